# Optimizing an MI355X kernel written in HIP

```python
import math
import jax, jax.numpy as jnp
from jax import lax
import numpy as np

D_MODEL = 1024
BATCH = 1
SEQ = 16384
DEPTH = 1
DEC_BATCH = 4
DEC_SEQ = 4096
PAST_LEN = 128

GRID_W = 64
N_Q_HEADS = 8
N_KV_HEADS = 2
HEAD_DIM = 64
ATTN_WIDTH = N_Q_HEADS * HEAD_DIM
KV_WIDTH = N_KV_HEADS * HEAD_DIM
Q_BLOCK = 128
ROPE_THETA = 10000.0
GLA_HEADS = 4
GLA_DK = 64
GLA_DV = 128
GLA_KEY_WIDTH = GLA_HEADS * GLA_DK
GLA_WIDTH = GLA_HEADS * GLA_DV
GATE_RANK = 16
GATE_NORMALIZER = 16.0
CHUNK = 64
MIX_WIDTH = ATTN_WIDTH + GLA_WIDTH
SPLIT_SIZES = (ATTN_WIDTH, KV_WIDTH, KV_WIDTH, ATTN_WIDTH,
               GLA_KEY_WIDTH, GLA_KEY_WIDTH, GLA_WIDTH, GLA_WIDTH,
               GATE_RANK, GATE_RANK)
IN_WIDTH = 2848
PLE_DIM = 256
EPS = 1e-6

kernel_name = "hymba_gqa_axialrope_bigla_encoder"


def rms_norm(x, w):
    xf = x.astype(jnp.float32)
    y = xf * lax.rsqrt(jnp.mean(xf * xf, axis=-1, keepdims=True) + EPS)
    return (y * w.astype(jnp.float32)).astype(x.dtype)


def axial_rope_tables(T):
    rows = T // GRID_W
    row_idx = jnp.repeat(jnp.arange(rows, dtype=jnp.float32), GRID_W)
    col_idx = jnp.tile(jnp.arange(GRID_W, dtype=jnp.float32), rows)
    half = HEAD_DIM // 2
    inv_freq = ROPE_THETA ** (-jnp.arange(0, half, 2, dtype=jnp.float32) / half)
    ang_r = row_idx[:, None] * inv_freq[None, :]
    ang_c = col_idx[:, None] * inv_freq[None, :]
    return jnp.cos(ang_r), jnp.sin(ang_r), jnp.cos(ang_c), jnp.sin(ang_c)


def apply_axial_rope(x, tables):
    cr, sr, cc, sc = (t[None, :, None, :] for t in tables)
    x_r1, x_r2, x_c1, x_c2 = jnp.split(x, 4, axis=-1)
    return jnp.concatenate([x_r1 * cr - x_r2 * sr, x_r2 * cr + x_r1 * sr,
                            x_c1 * cc - x_c2 * sc, x_c2 * cc + x_c1 * sc], axis=-1)


def block_attention(q, k, v):
    B, T, _, D = q.shape
    G = N_Q_HEADS // N_KV_HEADS
    nb = T // Q_BLOCK
    scale = D ** -0.5
    qb = q.reshape(B, nb, Q_BLOCK, N_KV_HEADS, G, D).transpose(1, 0, 3, 4, 2, 5)

    def one_block(q_blk):
        s = jnp.einsum('bkgqd,btkd->bkgqt', q_blk, k).astype(jnp.float32) * scale
        p = jax.nn.softmax(s, axis=-1)
        return jnp.einsum('bkgqt,btkd->bkgqd', p.astype(v.dtype), v)

    o = lax.map(one_block, qb)
    return o.transpose(1, 0, 4, 2, 3, 5).reshape(B, T, N_Q_HEADS * D)


def gla_chunked(q, k, v, g, include_diag):
    B, T, H, DK = q.shape
    DV = v.shape[-1]
    N = T // CHUNK

    def to_chunks(a):
        return a.astype(jnp.float32).reshape(B, N, CHUNK, H, a.shape[-1]).transpose(0, 3, 1, 2, 4)

    q, k, v, g = to_chunks(q) * (DK ** -0.5), to_chunks(k), to_chunks(v), to_chunks(g)
    b = jnp.cumsum(g, axis=3)
    b_last = b[:, :, :, -1:, :]
    q_dec = q * jnp.exp(b)
    a = jnp.einsum('bhncd,bhnsd->bhncs', q_dec, k * jnp.exp(-b))
    mask = jnp.tril(jnp.ones((CHUNK, CHUNK), dtype=bool), k=0 if include_diag else -1)
    a = jnp.where(mask, a, 0.0)
    o_intra = jnp.einsum('bhncs,bhnse->bhnce', a, v)
    kv = jnp.einsum('bhncd,bhnce->bhnde', k * jnp.exp(b_last - b), v)
    decay = jnp.exp(b_last[:, :, :, 0, :])

    def step(state, inp):
        dec, kv_c = inp
        return dec[..., None] * state + kv_c, state

    _, s_prev = lax.scan(step, jnp.zeros((B, H, DK, DV), jnp.float32),
                         (jnp.moveaxis(decay, 2, 0), jnp.moveaxis(kv, 2, 0)))
    s_prev = jnp.moveaxis(s_prev, 0, 2)
    o_inter = jnp.einsum('bhncd,bhnde->bhnce', q_dec, s_prev)
    return (o_intra + o_inter).transpose(0, 2, 3, 1, 4).reshape(B, T, H, DV)


def hybrid_layer(h, p, mix_norm, w_in, q_norm, k_norm, w_gate_up_fwd, b_gate_fwd,
                 w_gate_up_bwd, b_gate_bwd, gla_norm, w_out, ple_norm, w_ple_gate, w_ple_proj):
    B, T, _ = h.shape
    xn = rms_norm(h, mix_norm)
    z = xn @ w_in
    idx, acc = [], 0
    for s in SPLIT_SIZES[:-1]:
        acc += s
        idx.append(acc)
    (a_q, a_k, a_v, a_gate, l_q, l_k, l_v, l_gate, lr_f, lr_b) = jnp.split(z, idx, axis=-1)

    tables = axial_rope_tables(T)
    q = rms_norm(a_q.reshape(B, T, N_Q_HEADS, HEAD_DIM).astype(jnp.float32), q_norm)
    k = rms_norm(a_k.reshape(B, T, N_KV_HEADS, HEAD_DIM).astype(jnp.float32), k_norm)
    q = apply_axial_rope(q, tables)
    k = apply_axial_rope(k, tables)
    v = a_v.reshape(B, T, N_KV_HEADS, HEAD_DIM).astype(jnp.float32)
    o_attn = block_attention(q, k, v).astype(h.dtype)

    gq = l_q.reshape(B, T, GLA_HEADS, GLA_DK)
    gk = l_k.reshape(B, T, GLA_HEADS, GLA_DK)
    gv = l_v.reshape(B, T, GLA_HEADS, GLA_DV)
    g_f = jax.nn.log_sigmoid((lr_f @ w_gate_up_fwd + b_gate_fwd).astype(jnp.float32)) / GATE_NORMALIZER
    g_b = jax.nn.log_sigmoid((lr_b @ w_gate_up_bwd + b_gate_bwd).astype(jnp.float32)) / GATE_NORMALIZER
    g_f = g_f.reshape(B, T, GLA_HEADS, GLA_DK)
    g_b = g_b.reshape(B, T, GLA_HEADS, GLA_DK)
    o_fwd = gla_chunked(gq, gk, gv, g_f, include_diag=True)
    flip = lambda a: jnp.flip(a, axis=1)
    o_bwd = flip(gla_chunked(flip(gq), flip(gk), flip(gv), flip(g_b), include_diag=False))
    o_gla = rms_norm(o_fwd + o_bwd, gla_norm).reshape(B, T, GLA_WIDTH).astype(h.dtype)

    mixed = jnp.concatenate([o_attn * jax.nn.silu(a_gate), o_gla * jax.nn.silu(l_gate)], axis=-1)
    h = h + mixed @ w_out

    gate = jax.nn.sigmoid(rms_norm(h, ple_norm) @ w_ple_gate)
    return h + gate * (p @ w_ple_proj)


def setup_inputs(seed: int = 0) -> dict:
    key = jax.random.key(seed)
    ks = jax.random.split(key, 20)
    nrm = lambda k_, shape, s: jax.random.normal(k_, shape, jnp.float32) * s
    gain = lambda k_, shape: 1.0 + 0.05 * jax.random.normal(k_, shape, jnp.float32)
    return {
        "x_prompt": nrm(ks[0], (BATCH, SEQ, D_MODEL), 1.0),
        "x_sample": nrm(ks[1], (DEC_BATCH, DEC_SEQ, D_MODEL), 1.0),
        "p_prompt": nrm(ks[2], (DEPTH, BATCH, SEQ, PLE_DIM), 1.0),
        "p_sample": nrm(ks[3], (DEPTH, DEC_BATCH, DEC_SEQ, PLE_DIM), 1.0),
        "mix_norm": gain(ks[4], (DEPTH, D_MODEL)),
        "w_in": nrm(ks[5], (DEPTH, D_MODEL, IN_WIDTH), D_MODEL ** -0.5),
        "q_norm": gain(ks[6], (DEPTH, HEAD_DIM)),
        "k_norm": gain(ks[7], (DEPTH, HEAD_DIM)),
        "w_gate_up_fwd": nrm(ks[8], (DEPTH, GATE_RANK, GLA_KEY_WIDTH), GATE_RANK ** -0.5),
        "b_gate_fwd": nrm(ks[9], (DEPTH, GLA_KEY_WIDTH), 0.1),
        "w_gate_up_bwd": nrm(ks[10], (DEPTH, GATE_RANK, GLA_KEY_WIDTH), GATE_RANK ** -0.5),
        "b_gate_bwd": nrm(ks[11], (DEPTH, GLA_KEY_WIDTH), 0.1),
        "gla_norm": gain(ks[12], (DEPTH, GLA_DV)),
        "w_out": nrm(ks[13], (DEPTH, MIX_WIDTH, D_MODEL), MIX_WIDTH ** -0.5),
        "ple_norm": gain(ks[14], (DEPTH, D_MODEL)),
        "w_ple_gate": nrm(ks[15], (DEPTH, D_MODEL, D_MODEL), D_MODEL ** -0.5),
        "w_ple_proj": nrm(ks[16], (DEPTH, PLE_DIM, D_MODEL), PLE_DIM ** -0.5),
        "final_norm": gain(ks[17], (D_MODEL,)),
    }


def reference(x_prompt, x_sample, p_prompt, p_sample, mix_norm, w_in, q_norm, k_norm,
              w_gate_up_fwd, b_gate_fwd, w_gate_up_bwd, b_gate_bwd, gla_norm, w_out,
              ple_norm, w_ple_gate, w_ple_proj, final_norm):
    hp, hs = x_prompt, x_sample
    for i in range(DEPTH):
        lw = (mix_norm[i], w_in[i], q_norm[i], k_norm[i], w_gate_up_fwd[i], b_gate_fwd[i],
              w_gate_up_bwd[i], b_gate_bwd[i], gla_norm[i], w_out[i], ple_norm[i],
              w_ple_gate[i], w_ple_proj[i])
        hp = hybrid_layer(hp, p_prompt[i], *lw)
        hs = hybrid_layer(hs, p_sample[i], *lw)
    y_prompt = rms_norm(hp, final_norm)
    y_sample = rms_norm(hs, final_norm)
    return (y_prompt, y_sample)
```

```cpp
#include <hip/hip_runtime.h>
#include <hip/hip_bf16.h>
#include <cstdio>
#include <cstdint>
#include <cmath>
#ifndef MK_DEBUG
#define MK_DEBUG 1
#endif
__device__ __forceinline__ int mk_lane() { int l; asm volatile("v_mbcnt_lo_u32_b32 %0, -1, 0\n\tv_mbcnt_hi_u32_b32 %0, -1, %0" : "=v"(l)); return l; }
constexpr int NWAVES = 8;
constexpr int NTOK = 32768, DMODEL = 1024, NPR = 16384, INW = 2848, NPHYS = 3072, PLE = 256;
constexpr int NPHASE = 8;
constexpr float EPS = 1e-6f;
constexpr size_t MiB = 1u << 20;
constexpr size_t WS_CTL = 0, CTL_ZERO_BYTES = 64 * 1024;
constexpr size_t WS_ROPE_ROW = 1 * MiB, WS_ROPE_COL = 1 * MiB + 64 * 1024, WS_RS = 1 * MiB + 128 * 1024;
constexpr size_t WS_CONST = 1 * MiB + 256 * 1024;
constexpr int CO_QN = 0, CO_KN = 64, CO_GN = 128, CO_FN = 256, CO_BF = 1280, CO_BB = 1536, CO_WF = 1792, CO_WB = 1792 + 4096, CO_END = 1792 + 8192;
constexpr size_t WS_DEC = 2 * MiB;
constexpr size_t WS_SS = 3 * MiB, WS_SS2 = 5 * MiB;
constexpr size_t WS_WIN = 8 * MiB, WS_WOUT = 14 * MiB, WS_WPG = 16 * MiB, WS_WPP = 18 * MiB;
constexpr size_t WS_PB = 19 * MiB;
constexpr size_t WS_LR = 35 * MiB;
constexpr size_t WS_MIX = 40 * MiB;
constexpr size_t WS_KB = 104 * MiB, WS_VB = 112 * MiB;
constexpr size_t WS_AG = 120 * MiB, WS_LQ = 152 * MiB, WS_LK = 168 * MiB, WS_LV = 184 * MiB, WS_LG = 216 * MiB;
constexpr size_t WS_PPB = WS_AG;
constexpr size_t WS_H2B = WS_LV;
constexpr size_t WS_END = 248 * MiB;
constexpr size_t OUT_XB = 0, OUT_ST = 64 * MiB;
constexpr int CW_TMO = 0, CW_CODE = 1;
constexpr int CW_BAR = 4096;
constexpr int CW_DBG = 8192;
namespace pg8 {
#define PG8_LAS __attribute__((address_space(3)))
typedef unsigned short bf16_t;
typedef short bf16x8 __attribute__((ext_vector_type(8)));
typedef float f32x4 __attribute__((ext_vector_type(4)));
typedef unsigned u32x4 __attribute__((ext_vector_type(4)));
constexpr int BM = 256, BK = 64, HALF = 128, HTB = HALF * BK * 2  , STAGE_BYTES = 8 * HTB, NXCD = 8, WGM = 8;

__host__ __device__ __forceinline__ int lds_byte(int r, int c) { const int st = (r >> 4) * 2 + (c >> 5), rr = r & 15, cc = c & 31, ob = rr * 64 + cc * 2; return st * 1024 + (ob ^ (((ob >> 9) & 1) << 5)); }
__host__ __device__ __forceinline__ void stage_rc(int b, int& R, int& C) { const int st = b / 1024, sb = b % 1024, swz = sb ^ (((sb >> 9) & 1) << 5); R = (st >> 1) * 16 + swz / 64; C = (st & 1) * 32 + (swz % 64) / 2; }
__host__ __device__ __forceinline__ int perm32(int rho) { const int n = rho >> 4, i = rho & 15; return 8 * (i >> 2) + 4 * n + (i & 3); }

struct Unit { int pm, pn; };
struct Gemm { const bf16_t* A; const bf16_t* Bt; int M, N, K; };

struct StaticOrder {
    int nM, nN, nwg, G, c;
    __host__ __device__ void init(int M, int N, int G_, int c_) { nM = M / BM; nN = N / BM; nwg = nM * nN; G = G_; c = c_; }
    __host__ __device__ bool next(int i, Unit& u) const {
        const long L = (long)i * G + c; if (L >= nwg) return false;
        int wgid = (int)L; { const int q = nwg / NXCD, r = nwg % NXCD, xcd = wgid % NXCD, off = wgid / NXCD; wgid = (xcd < r ? xcd * (q + 1) : r * (q + 1) + (xcd - r) * q) + off; }
        const int nig = WGM * nN, gid = wgid / nig, fm = gid * WGM, gsz = (nM - fm) < WGM ? (nM - fm) : WGM;
        u.pm = fm + ((wgid % nig) % gsz); u.pn = (wgid % nig) / gsz; return true;
    }
    __device__ __forceinline__ void a_ready(const Unit&) const {}
    __device__ __forceinline__ void done(const Unit&) const {}
};

__device__ __forceinline__ unsigned cvt_pk_bf16(float lo, float hi) { unsigned r; asm volatile("v_cvt_pk_bf16_f32 %0, %1, %2" : "=v"(r) : "v"(lo), "v"(hi)); return r; }
typedef float f32x2 __attribute__((ext_vector_type(2)));
__device__ __forceinline__ float silu_f(float x) { return x / (1.f + __expf(-x)); }
__device__ __forceinline__ u32x4 pack8(const float* v) { u32x4 w; w.x = cvt_pk_bf16(v[0], v[1]); w.y = cvt_pk_bf16(v[2], v[3]); w.z = cvt_pk_bf16(v[4], v[5]); w.w = cvt_pk_bf16(v[6], v[7]); return w; }
constexpr float ATT_C2 = 0.125f * 1.4426950408889634f;
constexpr float NORM_EPS = 1e-6f;

struct EpiPlainBf16 {
    static constexpr bool PERM = true, AFTER_DRAIN = false;
    bf16_t* O; int ldc;
    __device__ __forceinline__ void operator()(const f32x4 (&acc)[2][2][4][2], const Unit& u, int wr, int wc, int fr, int fq) const {
        const int row0 = u.pm * BM + wr * 64 + fr, col0 = u.pn * BM + wc * 32 + 8 * fq;
#pragma unroll
        for (int ai = 0; ai < 2; ++ai)
#pragma unroll
            for (int m = 0; m < 4; ++m) { bf16_t* rowp = O + (size_t)(row0 + ai * HALF + m * 16) * ldc + col0;
#pragma unroll
                for (int bj = 0; bj < 2; ++bj) { const f32x4 v0 = acc[ai][bj][m][0], v1 = acc[ai][bj][m][1];
                    u32x4 w; w.x = cvt_pk_bf16(v0[0], v0[1]); w.y = cvt_pk_bf16(v0[2], v0[3]); w.z = cvt_pk_bf16(v1[0], v1[1]); w.w = cvt_pk_bf16(v1[2], v1[3]);
                    *(u32x4*)(rowp + bj * HALF) = w; } }
    }
};

struct EpiInProj {
    static constexpr bool PERM = true, AFTER_DRAIN = false;
    unsigned char* ws;
    template <class T> __device__ __forceinline__ T* at(unsigned byteoff) const { return (T*)(ws + byteoff); }
    __device__ __forceinline__ void operator()(const f32x4 (&acc)[2][2][4][2], const Unit& u, int wr, int wc, int fr, int fq) const {
        const int pn = u.pn, rowb = u.pm * BM + wr * 64 + fr;
        if (pn < 2 || (pn == 2 && wc < 2)) {
            const bool isq = pn < 2;
            const float* nw = at<const float>((unsigned)WS_CONST + (isq ? CO_QN : CO_KN) * 4u);
            const int d1 = 8 * fq + 16 * (fq >> 1);
            float n1[8], n2[8];
#pragma unroll
            for (int j = 0; j < 8; ++j) { n1[j] = nw[d1 + j]; n2[j] = nw[d1 + 16 + j]; }
            const float osc = isq ? ATT_C2 : 1.f;
            const unsigned dstoff = isq ? (unsigned)WS_MIX + ((4 * pn + wc) * 64 + d1) * 2u : (unsigned)WS_KB + (wc * 64 + d1) * 2u; const unsigned pitchb = isq ? 2048u : 256u;
#pragma unroll
            for (int ai = 0; ai < 2; ++ai)
#pragma unroll
                for (int m = 0; m < 4; ++m) {
                    const int row = rowb + ai * HALF + m * 16; const float rsv = *at<const float>((unsigned)WS_RS + (unsigned)row * 4u);
                    float a[8], b[8]; float ss = 0.f;
#pragma unroll
                    for (int j = 0; j < 8; ++j) { a[j] = acc[ai][0][m][j >> 2][j & 3] * rsv; b[j] = acc[ai][1][m][j >> 2][j & 3] * rsv; ss += a[j] * a[j] + b[j] * b[j]; }
                    ss += __shfl_xor(ss, 16); ss += __shfl_xor(ss, 32);
                    const float inv = rsqrtf(ss * (1.0f / 64.0f) + NORM_EPS);
                    const int t = row < 16384 ? row : ((row - 16384) & 4095);
                    const f32x2* tb = at<const f32x2>((fq < 2 ? (unsigned)WS_ROPE_ROW + (unsigned)(t >> 6) * 128u : (unsigned)WS_ROPE_COL + (unsigned)(t & 63) * 128u) + 64u * (fq & 1));
                    float o1[8], o2[8];
#pragma unroll
                    for (int j = 0; j < 8; ++j) { const f32x2 cs = tb[j]; const float x1 = a[j] * inv * n1[j], x2 = b[j] * inv * n2[j];
                        o1[j] = (x1 * cs.x - x2 * cs.y) * osc; o2[j] = (x2 * cs.x + x1 * cs.y) * osc; }
                    bf16_t* p = at<bf16_t>(dstoff + (unsigned)row * pitchb);
                    *(u32x4*)p = pack8(o1); *(u32x4*)(p + 16) = pack8(o2);
                }
        } else {
            unsigned dsto = 0, pitchb = 0, cbase = 0; bool act = false;
            if (pn <= 4)       { dsto = (unsigned)WS_AG; pitchb = 1024; cbase = (pn - 3) * 256; act = true; }
            else if (pn == 5)  { dsto = (unsigned)WS_LQ; pitchb = 512; cbase = 0; }
            else if (pn == 6)  { dsto = (unsigned)WS_LK; pitchb = 512; cbase = 0; }
            else if (pn <= 8)  { dsto = (unsigned)WS_LV; pitchb = 1024; cbase = (pn - 7) * 256; }
            else if (pn <= 10) { dsto = (unsigned)WS_LG; pitchb = 1024; cbase = (pn - 9) * 256; act = true; }
#pragma unroll
            for (int ai = 0; ai < 2; ++ai)
#pragma unroll
                for (int m = 0; m < 4; ++m) {
                    const int row = rowb + ai * HALF + m * 16; const float rsv = *at<const float>((unsigned)WS_RS + (unsigned)row * 4u);
#pragma unroll
                    for (int bj = 0; bj < 2; ++bj) {
                        float v[8];
#pragma unroll
                        for (int j = 0; j < 8; ++j) v[j] = acc[ai][bj][m][j >> 2][j & 3] * rsv;
                        if (pn == 11) {
                            if (wc == 0 && bj == 0) { float* p = at<float>((unsigned)WS_LR + ((unsigned)row * 32u + 8u * fq) * 4u); *(f32x4*)p = (f32x4){v[0], v[1], v[2], v[3]}; *(f32x4*)(p + 4) = (f32x4){v[4], v[5], v[6], v[7]}; }
                        } else if (pn == 2) {
                            *at<u32x4>((unsigned)WS_VB + ((unsigned)row * 128u + (wc - 2) * 64 + 32 * bj + 8 * fq) * 2u) = pack8(v);
                        } else {
                            if (act) {
#pragma unroll
                                for (int j = 0; j < 8; ++j) v[j] = silu_f(v[j]);
                            }
                            *at<u32x4>(dsto + (unsigned)row * pitchb + (cbase + bj * HALF + wc * 32 + 8 * fq) * 2u) = pack8(v);
                        }
                    }
                }
        }
    }
};

struct EpiOutProj {
    static constexpr bool PERM = true, AFTER_DRAIN = false;
    const float* xp; const float* xs; float* OUT; unsigned char* ws;
    __device__ __forceinline__ void operator()(const f32x4 (&acc)[2][2][4][2], const Unit& u, int wr, int wc, int fr, int fq) const {
        const int rowb = u.pm * BM + wr * 64 + fr, col0 = u.pn * BM + wc * 32 + 8 * fq;
#pragma unroll
        for (int ai = 0; ai < 2; ++ai)
#pragma unroll
            for (int m = 0; m < 4; ++m) {
                const int row = rowb + ai * HALF + m * 16;
                const float* xr = (row < 16384 ? xp + (size_t)row * 1024 : xs + (size_t)(row - 16384) * 1024) + col0;
                float ss = 0.f;
#pragma unroll
                for (int bj = 0; bj < 2; ++bj) {
                    const f32x4 x0 = *(const f32x4*)(xr + bj * HALF), x1 = *(const f32x4*)(xr + bj * HALF + 4);
                    const f32x4 v0 = acc[ai][bj][m][0] + x0, v1 = acc[ai][bj][m][1] + x1;
                    float* o = OUT + (size_t)row * 1024 + col0 + bj * HALF; *(f32x4*)o = v0; *(f32x4*)(o + 4) = v1;
                    u32x4 w; w.x = cvt_pk_bf16(v0[0], v0[1]); w.y = cvt_pk_bf16(v0[2], v0[3]); w.z = cvt_pk_bf16(v1[0], v1[1]); w.w = cvt_pk_bf16(v1[2], v1[3]);
                    *(u32x4*)(ws + ((unsigned)WS_H2B + ((unsigned)row * 1024u + col0 + bj * HALF) * 2u)) = w;
                    ss += (v0[0] * v0[0] + v0[1] * v0[1]) + (v0[2] * v0[2] + v0[3] * v0[3]) + (v1[0] * v1[0] + v1[1] * v1[1]) + (v1[2] * v1[2] + v1[3] * v1[3]);
                }
                ss += __shfl_xor(ss, 16); ss += __shfl_xor(ss, 32);
                if (fq == 0) *(float*)(ws + ((unsigned)WS_SS + ((unsigned)row * 16u + u.pn * 4 + wc) * 4u)) = ss;
            }
    }
};

struct EpiPle {
    static constexpr bool PERM = true, AFTER_DRAIN = false;
    float* OUT; unsigned char* ws;
    __device__ __forceinline__ void operator()(const f32x4 (&acc)[2][2][4][2], const Unit& u, int wr, int wc, int fr, int fq) const {
        const int rowb = u.pm * BM + wr * 64 + fr, col0 = u.pn * BM + wc * 32 + 8 * fq;
#pragma unroll
        for (int ai = 0; ai < 2; ++ai)
#pragma unroll
            for (int m = 0; m < 4; ++m) {
                const int row = rowb + ai * HALF + m * 16;
                const f32x4* sp = (const f32x4*)(ws + ((unsigned)WS_SS + (unsigned)row * 64u));
                const f32x4 s0 = sp[0], s1 = sp[1], s2 = sp[2], s3 = sp[3];
                const float tot = ((s0[0] + s0[1]) + (s0[2] + s0[3])) + ((s1[0] + s1[1]) + (s1[2] + s1[3])) + ((s2[0] + s2[1]) + (s2[2] + s2[3])) + ((s3[0] + s3[1]) + (s3[2] + s3[3]));
                const float rs2 = rsqrtf(tot * (1.0f / 1024.0f) + NORM_EPS);
                float ss = 0.f;
#pragma unroll
                for (int bj = 0; bj < 2; ++bj) {
                    float* o = OUT + (size_t)row * 1024 + col0 + bj * HALF;
                    const f32x4 h0 = *(const f32x4*)o, h1 = *(const f32x4*)(o + 4);
                    const u32x4 pw = *(const u32x4*)(ws + ((unsigned)WS_PPB + ((unsigned)row * 1024u + col0 + bj * HALF) * 2u));
                    float hv[8] = {h0[0], h0[1], h0[2], h0[3], h1[0], h1[1], h1[2], h1[3]};
#pragma unroll
                    for (int j = 0; j < 8; ++j) {
                        const float g = acc[ai][bj][m][j >> 2][j & 3] * rs2;
                        const float sg = 1.f / (1.f + __expf(-g));
                        const unsigned w = pw[j >> 1]; const float pp = __uint_as_float((j & 1) ? (w & 0xffff0000u) : (w << 16));
                        hv[j] = hv[j] + sg * pp; ss += hv[j] * hv[j];
                    }
                    *(f32x4*)o = (f32x4){hv[0], hv[1], hv[2], hv[3]}; *(f32x4*)(o + 4) = (f32x4){hv[4], hv[5], hv[6], hv[7]};
                }
                ss += __shfl_xor(ss, 16); ss += __shfl_xor(ss, 32);
                if (fq == 0) *(float*)(ws + ((unsigned)WS_SS2 + ((unsigned)row * 16u + u.pn * 4 + wc) * 4u)) = ss;
            }
    }
};


template <class Epi, class Sched, bool ALIGN_EPI = false, bool SP2 = false>
__device__ __forceinline__ void gemm_phase(PG8_LAS unsigned char* lds, const Gemm g, const Sched& S, const Epi& E, int wave0) {
    const int lane = mk_lane(), wid = __builtin_amdgcn_readfirstlane(wave0), tid = wid * 64 + lane, wr = wid >> 2, wc = wid & 3, fr = lane & 15, fq = lane >> 4;
    const int K = g.K, nt = K / BK;
    unsigned voffA[2], voffB[2];
#pragma unroll
    for (int i = 0; i < 2; ++i) { int R, C; stage_rc(tid * 16 + i * 8192, R, C); const int Rb = Epi::PERM ? ((R & ~31) + perm32(R & 31)) : R;
        voffA[i] = (unsigned)(R * K + C) * 2u; voffB[i] = (unsigned)(Rb * K + C) * 2u; }
    const size_t kstep = (size_t)(BK * 2);
    const size_t hstep = (size_t)HALF * K * 2;
    const size_t tstep = 2 * hstep;
    const unsigned ldsw = (unsigned)wid * 1024u;
    const int aoff = lds_byte(wr * 64 + fr, fq * 8), boff = lds_byte(wc * 32 + fr, fq * 8);
#define PG8_SA(b, h) (((b) * 2 + (h)) * HTB)
#define PG8_SB(b, h) ((4 + (b) * 2 + (h)) * HTB)
#define PG8_STAGE(bufoff, gbase, voff) do { _Pragma("unroll") for (int _i = 0; _i < 2; ++_i) \
        __builtin_amdgcn_global_load_lds((const unsigned*)((const char*)(gbase) + (voff)[_i]), (PG8_LAS unsigned*)(lds + (bufoff) + ldsw + _i * 8192), 16, 0, 0); } while (0)
#define PG8_LDA(dst, b, h) do { _Pragma("unroll") for (int m = 0; m < 4; ++m) _Pragma("unroll") for (int k = 0; k < 2; ++k) dst[m][k] = *(const PG8_LAS bf16x8*)(lds + PG8_SA(b, h) + aoff + m * 2048 + k * 1024); } while (0)
#define PG8_LDB(dst, b, h) do { _Pragma("unroll") for (int n = 0; n < 2; ++n) _Pragma("unroll") for (int k = 0; k < 2; ++k) dst[n][k] = *(const PG8_LAS bf16x8*)(lds + PG8_SB(b, h) + boff + n * 2048 + k * 1024); } while (0)
#define PG8_MMA(ai, bj, At, Bt) do { __builtin_amdgcn_s_setprio(1); _Pragma("unroll") for (int m = 0; m < 4; ++m) _Pragma("unroll") for (int n = 0; n < 2; ++n) _Pragma("unroll") for (int k = 0; k < 2; ++k) \
        acc[ai][bj][m][n] = __builtin_amdgcn_mfma_f32_16x16x32_bf16(Bt[n][k], At[m][k], acc[ai][bj][m][n], 0, 0, 0); __builtin_amdgcn_s_setprio(0); } while (0)
#define PG8_WAIT_V(n) asm volatile("s_waitcnt vmcnt(" #n ")" ::: "memory")
#define PG8_WAIT_L(n) asm volatile("s_waitcnt lgkmcnt(" #n ")" ::: "memory")
#define PG8_BAR __builtin_amdgcn_s_barrier()
#define PG8_SCHED __builtin_amdgcn_sched_barrier(0)
    Unit cur, nxt; int ui = 0;
    if (!S.next(0, cur)) return;
    f32x4 acc[2][2][4][2];
#pragma unroll
    for (int a = 0; a < 2; ++a)
#pragma unroll
        for (int b = 0; b < 2; ++b)
#pragma unroll
            for (int m = 0; m < 4; ++m)
#pragma unroll
                for (int n = 0; n < 2; ++n) acc[a][b][m][n] = (f32x4){0.f, 0.f, 0.f, 0.f};
    bf16x8 At[4][2], B0[2][2], B1[2][2];
    const char* cA = (const char*)g.A + (size_t)cur.pm * tstep; const char* cB = (const char*)g.Bt + (size_t)cur.pn * tstep;
    S.a_ready(cur);
    if constexpr (SP2) {
        PG8_STAGE(PG8_SB(0, 0), cB, voffB); PG8_STAGE(PG8_SB(0, 1), cB + hstep, voffB); PG8_STAGE(PG8_SA(0, 0), cA, voffA); PG8_STAGE(PG8_SA(0, 1), cA + hstep, voffA);
        if (wr == 1) PG8_BAR;
        PG8_WAIT_V(2); PG8_BAR;
        PG8_STAGE(PG8_SB(1, 0), cB + kstep, voffB); PG8_STAGE(PG8_SA(1, 0), cA + kstep, voffA); PG8_STAGE(PG8_SB(1, 1), cB + hstep + kstep, voffB);
        PG8_WAIT_V(6); PG8_BAR;
    } else {
        PG8_STAGE(PG8_SB(0, 0), cB, voffB); PG8_STAGE(PG8_SA(0, 0), cA, voffA); PG8_STAGE(PG8_SB(0, 1), cB + hstep, voffB); PG8_STAGE(PG8_SA(0, 1), cA + hstep, voffA);
        if (wr == 1) PG8_BAR;
        PG8_WAIT_V(4); PG8_BAR;
        PG8_STAGE(PG8_SB(1, 0), cB + kstep, voffB); PG8_STAGE(PG8_SA(1, 0), cA + kstep, voffA); PG8_STAGE(PG8_SB(1, 1), cB + hstep + kstep, voffB);
        PG8_WAIT_V(6); PG8_BAR;
    }
    for (;;) {
        const bool has_next = S.next(ui + 1, nxt);
        const char* nA = has_next ? (const char*)g.A + (size_t)nxt.pm * tstep : cA; const char* nB = has_next ? (const char*)g.Bt + (size_t)nxt.pn * tstep : cB;
        for (int t = 0; t < nt; t += 2) {
            const bool last = (t == nt - 2);
            const char* a1 = cA + (size_t)(t + 1) * kstep;
            const char* a2 = last ? nA : cA + (size_t)(t + 2) * kstep; const char* b2 = last ? nB : cB + (size_t)(t + 2) * kstep;
            const char* a3 = a2 + kstep; const char* b3 = b2 + kstep;
            if (last && has_next) S.a_ready(nxt);
            if constexpr (SP2) {
            PG8_LDB(B0, 0, 0); PG8_LDB(B1, 0, 1); PG8_SCHED; PG8_LDA(At, 0, 0); PG8_STAGE(PG8_SA(1, 1), a1 + hstep, voffA);
            PG8_WAIT_V(8); PG8_WAIT_L(0); PG8_BAR; PG8_MMA(0, 0, At, B0); PG8_MMA(0, 1, At, B1); PG8_BAR; PG8_SCHED;
            PG8_LDA(At, 0, 1); PG8_STAGE(PG8_SB(0, 0), b2, voffB); PG8_STAGE(PG8_SB(0, 1), b2 + hstep, voffB); PG8_STAGE(PG8_SA(0, 0), a2, voffA);
            PG8_WAIT_V(8); PG8_WAIT_L(0); PG8_BAR; PG8_MMA(1, 0, At, B0); PG8_MMA(1, 1, At, B1); PG8_BAR; PG8_SCHED;
            PG8_LDB(B0, 1, 0); PG8_LDB(B1, 1, 1); PG8_SCHED; PG8_LDA(At, 1, 0); PG8_STAGE(PG8_SA(0, 1), a2 + hstep, voffA);
            PG8_WAIT_V(8); PG8_WAIT_L(0); PG8_BAR; PG8_MMA(0, 0, At, B0); PG8_MMA(0, 1, At, B1); PG8_BAR; PG8_SCHED;
            PG8_LDA(At, 1, 1); PG8_STAGE(PG8_SB(1, 0), b3, voffB); PG8_STAGE(PG8_SB(1, 1), b3 + hstep, voffB); PG8_STAGE(PG8_SA(1, 0), a3, voffA);
            PG8_WAIT_V(8); PG8_WAIT_L(0); PG8_BAR; PG8_MMA(1, 0, At, B0); PG8_MMA(1, 1, At, B1); PG8_BAR; PG8_SCHED;
            } else {
            PG8_LDB(B0, 0, 0); PG8_SCHED; PG8_LDA(At, 0, 0); PG8_STAGE(PG8_SA(1, 1), a1 + hstep, voffA);
            PG8_WAIT_L(8); PG8_BAR; PG8_WAIT_L(0); PG8_MMA(0, 0, At, B0); PG8_BAR; PG8_SCHED;
            PG8_LDB(B1, 0, 1); PG8_STAGE(PG8_SB(0, 0), b2, voffB);
            PG8_BAR; PG8_WAIT_L(0); PG8_MMA(0, 1, At, B1); PG8_BAR;
            PG8_LDA(At, 0, 1); PG8_STAGE(PG8_SA(0, 0), a2, voffA);
            PG8_BAR; PG8_WAIT_L(0); PG8_MMA(1, 0, At, B0); PG8_BAR; PG8_SCHED;
            PG8_STAGE(PG8_SB(0, 1), b2 + hstep, voffB);
            PG8_WAIT_V(6); PG8_BAR; PG8_MMA(1, 1, At, B1); PG8_BAR;
            PG8_LDB(B0, 1, 0); PG8_SCHED; PG8_LDA(At, 1, 0); PG8_STAGE(PG8_SA(0, 1), a2 + hstep, voffA);
            PG8_WAIT_L(8); PG8_BAR; PG8_WAIT_L(0); PG8_MMA(0, 0, At, B0); PG8_BAR; PG8_SCHED;
            PG8_LDB(B1, 1, 1); PG8_STAGE(PG8_SB(1, 0), b3, voffB);
            PG8_BAR; PG8_WAIT_L(0); PG8_MMA(0, 1, At, B1); PG8_BAR;
            PG8_LDA(At, 1, 1); PG8_STAGE(PG8_SA(1, 0), a3, voffA);
            PG8_BAR; PG8_WAIT_L(0); PG8_MMA(1, 0, At, B0); PG8_BAR; PG8_SCHED;
            PG8_STAGE(PG8_SB(1, 1), b3 + hstep, voffB);
            PG8_WAIT_V(6); PG8_BAR; PG8_MMA(1, 1, At, B1); PG8_BAR;
            }
        }
        if constexpr (ALIGN_EPI) { if (wr == 0) PG8_BAR; }
        if constexpr (!Epi::AFTER_DRAIN) { E(acc, cur, wr, wc, fr, fq); S.done(cur); }
        if (!has_next) break;
#pragma unroll
        for (int a = 0; a < 2; ++a)
#pragma unroll
            for (int b = 0; b < 2; ++b)
#pragma unroll
                for (int m = 0; m < 4; ++m)
#pragma unroll
                    for (int n = 0; n < 2; ++n) acc[a][b][m][n] = (f32x4){0.f, 0.f, 0.f, 0.f};
        cur = nxt; cA = nA; cB = nB; ++ui;
        if constexpr (ALIGN_EPI) { if (wr == 1) PG8_BAR; }
    }
    PG8_WAIT_V(0);
    if constexpr (!ALIGN_EPI) { if (wr == 0) PG8_BAR; }
    PG8_BAR;
    if constexpr (Epi::AFTER_DRAIN) { E.fused(acc, cur, wr, wc, fr, fq, lds, wid, lane); S.done(cur); }
#undef PG8_SA
#undef PG8_SB
#undef PG8_STAGE
#undef PG8_LDA
#undef PG8_LDB
#undef PG8_MMA
#undef PG8_WAIT_V
#undef PG8_WAIT_L
#undef PG8_BAR
#undef PG8_SCHED
}
}
#include <hip/hip_bf16.h>
#include <cmath>
namespace attn_body {
using bf16=__hip_bfloat16;
using bf16x8=__attribute__((ext_vector_type(8)))short;
using s16x4=__attribute__((ext_vector_type(4)))short;
using f32x16=__attribute__((ext_vector_type(16)))float;
using u32x4=__attribute__((ext_vector_type(4)))unsigned;
constexpr int D=64,QP=1024,KP=128,GP=512;
constexpr int NW=8,QBLK=32,QB=QBLK*NW,KVBLK=64;
constexpr int ATTN_UNIT_ROWS=QB;
__device__ __forceinline__ int crow(int r,int hi){return (r&3)+8*(r>>2)+4*hi;}
#define SBAR() __builtin_amdgcn_sched_barrier(0)
__device__ __forceinline__ void cmask(f32x16&p0,f32x16&p1,int jb,int qrel,int hi){
  const float NEG=-INFINITY; int kb=64*jb+4*hi;
  #pragma unroll
  for(int r=0;r<16;++r){int kv=kb+(r&3)+8*(r>>2); if(kv>qrel)p0[r]=NEG; if(kv+32>qrel)p1[r]=NEG;}
}

constexpr int NSLOT=3, SLOTB=8192;
constexpr int LDS_K=0, LDS_V=NSLOT*SLOTB, LDS_WS=2*NSLOT*SLOTB, LDS_OST=LDS_WS+NW*64*4, LDS_BYTES=LDS_OST+NW*4096;
constexpr float C2=0.125f*1.4426950408889634f;
__device__ __forceinline__ void glds16(const void*gsrc,unsigned lds_dst){unsigned keep;
  asm volatile("s_mov_b32 %0, m0\n\ts_mov_b32 m0, %2\n\ts_nop 0\n\tglobal_load_lds_dwordx4 %1, off\n\ts_mov_b32 m0, %0":"=&s"(keep):"v"(gsrc),"s"(lds_dst):"memory");}
__device__ __forceinline__ float max3f(float a,float b,float c){float r;asm("v_max3_f32 %0, %1, %2, %3":"=v"(r):"v"(a),"v"(b),"v"(c));return r;}
__device__ __forceinline__ float max2f(float a,float b){float r;asm("v_max_f32_e32 %0, %1, %2":"=v"(r):"v"(a),"v"(b));return r;}
__device__ __forceinline__ float fadd_s(float a,float b){float r;asm("v_add_f32_e32 %0, %1, %2":"=v"(r):"v"(a),"v"(b));return r;}
__device__ __forceinline__ float fsub_s(float a,float b){float r;asm("v_sub_f32_e32 %0, %1, %2":"=v"(r):"v"(a),"v"(b));return r;}
typedef float f32x2_t __attribute__((ext_vector_type(2))); typedef __bf16 bf16x2_t __attribute__((ext_vector_type(2)));
__device__ __forceinline__ unsigned cvtpk_s(float lo,float hi){f32x2_t v={lo,hi};bf16x2_t b=__builtin_convertvector(v,bf16x2_t);return __builtin_bit_cast(unsigned,b);}
#define WAIT_BAR(N) asm volatile("s_waitcnt vmcnt(" #N ") lgkmcnt(0)\n\ts_barrier":::"memory")

__device__ __forceinline__ void qkt(f32x16&p0,f32x16&p1,const char*Kslot,const bf16x8*qr,const f32x16&negm,int r32,int hi){
  const char*kb=Kslot+hi*1024+r32*16;
  #pragma unroll
  for(int d0=0;d0<4;++d0){
    const bf16x8 b0=*reinterpret_cast<const bf16x8*>(kb+d0*2048);
    const bf16x8 b1=*reinterpret_cast<const bf16x8*>(kb+d0*2048+512);
    if(d0==0){p0=__builtin_amdgcn_mfma_f32_32x32x16_bf16(b0,qr[0],negm,0,0,0);p1=__builtin_amdgcn_mfma_f32_32x32x16_bf16(b1,qr[0],negm,0,0,0);}
    else{p0=__builtin_amdgcn_mfma_f32_32x32x16_bf16(b0,qr[d0],p0,0,0,0);p1=__builtin_amdgcn_mfma_f32_32x32x16_bf16(b1,qr[d0],p1,0,0,0);}}
}
typedef __attribute__((address_space(3))) const char* lds_cptr;
typedef short v4i16_t __attribute__((ext_vector_type(4)));
__device__ __forceinline__ void kload8(bf16x8*kf,lds_cptr kp){
  kf[0]=*(const __attribute__((address_space(3))) bf16x8*)(kp);      kf[1]=*(const __attribute__((address_space(3))) bf16x8*)(kp+512);
  kf[2]=*(const __attribute__((address_space(3))) bf16x8*)(kp+2048); kf[3]=*(const __attribute__((address_space(3))) bf16x8*)(kp+2560);
  kf[4]=*(const __attribute__((address_space(3))) bf16x8*)(kp+4096); kf[5]=*(const __attribute__((address_space(3))) bf16x8*)(kp+4608);
  kf[6]=*(const __attribute__((address_space(3))) bf16x8*)(kp+6144); kf[7]=*(const __attribute__((address_space(3))) bf16x8*)(kp+6656);
}
__device__ __forceinline__ void kload2(bf16x8*kf,lds_cptr kp,int j){ kf[2*j]=*(const __attribute__((address_space(3))) bf16x8*)(kp+j*2048); kf[2*j+1]=*(const __attribute__((address_space(3))) bf16x8*)(kp+j*2048+512); }
__device__ __forceinline__ s16x4 vtr(lds_cptr p){ return __builtin_bit_cast(s16x4,__builtin_amdgcn_ds_read_tr16_b64_v4i16((__attribute__((address_space(3))) v4i16_t*)p)); }
__device__ __forceinline__ float rowmax(const f32x16&p0,const f32x16&p1){
  float a=max3f(p0[0],p0[1],p1[0]),b=max3f(p0[2],p0[3],p1[1]);a=max3f(a,p1[2],p1[3]);
  #pragma unroll
  for(int r=4;r<16;r+=4){a=max3f(a,p0[r],p0[r+1]);b=max3f(b,p0[r+2],p0[r+3]);a=max3f(a,p1[r],p1[r+1]);b=max3f(b,p1[r+2],p1[r+3]);}
  const float m=max2f(a,b);
  auto rr=__builtin_amdgcn_permlane32_swap(__float_as_uint(m),__float_as_uint(m),false,false);
  return max2f(__uint_as_float(rr[0]),__uint_as_float(rr[1]));
}
__device__ __forceinline__ void pv(f32x16*o,int vb,bf16x8 pa0,bf16x8 pa1,bf16x8 pa2,bf16x8 pa3){
  #pragma unroll
  for(int d0=0;d0<2;++d0){s16x4 lo[4],hi[4];
    #pragma unroll
    for(int ks=0;ks<4;++ks){
      asm volatile("ds_read_b64_tr_b16 %0,%1 offset:%c2":"=&v"(lo[ks]):"v"(vb),"i"(d0*4096+ks*1024):"memory");
      asm volatile("ds_read_b64_tr_b16 %0,%1 offset:%c2":"=&v"(hi[ks]):"v"(vb),"i"(d0*4096+ks*1024+512):"memory");}
    asm volatile("s_waitcnt lgkmcnt(0)":::"memory");SBAR();
    #define PK(k) (bf16x8){lo[k][0],lo[k][1],lo[k][2],lo[k][3],hi[k][0],hi[k][1],hi[k][2],hi[k][3]}
    o[d0]=__builtin_amdgcn_mfma_f32_32x32x16_bf16(pa0,PK(0),o[d0],0,0,0);
    o[d0]=__builtin_amdgcn_mfma_f32_32x32x16_bf16(pa1,PK(1),o[d0],0,0,0);
    o[d0]=__builtin_amdgcn_mfma_f32_32x32x16_bf16(pa2,PK(2),o[d0],0,0,0);
    o[d0]=__builtin_amdgcn_mfma_f32_32x32x16_bf16(pa3,PK(3),o[d0],0,0,0);
    #undef PK
  }
}

#ifndef ATTN_STORE16
#define ATTN_STORE16(p,v) (*(u32x4*)(p)=(v))
#endif
template<int THRL> __device__ __forceinline__ void attn_unit(long rowbase,int T,int h,int qb,const bf16*Q,const bf16*__restrict__ K,const bf16*__restrict__ V,bf16*O,const bf16*__restrict__ AG,char*shm,int wave0){
  const int lane=mk_lane(),r32=lane&31,hi=lane>>5; const int wid=__builtin_amdgcn_readfirstlane(wave0);
  const int q0=qb*QB;
  const bf16*Qw=Q+(rowbase+q0+wid*QBLK)*QP+h*D;
  const bf16*Kh=K+rowbase*KP+(h>>2)*D,*Vh=V+rowbase*KP+(h>>2)*D;
  const unsigned lds0=(unsigned)(uintptr_t)shm;
  float*wsf=(float*)(shm+LDS_WS)+wid*64;
  const bf16*ksrc=Kh+(long)lane*KP+wid*8;
  const bf16*vsrc=Vh+(long)(16*(wid&3)+(lane>>2))*KP+(wid>>2)*32+(lane&3)*8;
  const unsigned kdst=lds0+LDS_K+wid*1024, vdst=lds0+LDS_V+wid*1024;
  #define DMA_K(t,slot) glds16(ksrc+(long)(t)*KVBLK*KP,(unsigned)__builtin_amdgcn_readfirstlane(kdst+(slot)))
  #define DMA_V(t,slot) glds16(vsrc+(long)(t)*KVBLK*KP,(unsigned)__builtin_amdgcn_readfirstlane(vdst+(slot)))
  const int vb0=(int)(lds0+LDS_V)+((lane>>4)&1)*32+(lane&3)*8+(4*hi+((lane&15)>>2))*64;
  const char*Kbase=shm+LDS_K; bf16x8 kf[8];
  const lds_cptr shm3=(lds_cptr)shm; const lds_cptr kp0=shm3+LDS_K+hi*1024+r32*16; const lds_cptr vp0=shm3+LDS_V+((lane>>4)&1)*32+(lane&3)*8+(4*hi+((lane&15)>>2))*64;
  const int NT=T/KVBLK;
  DMA_K(0,0);DMA_V(0,0);DMA_K(1,SLOTB);
  bf16x8 qr[4];
  #pragma unroll
  for(int d0=0;d0<4;++d0)qr[d0]=*reinterpret_cast<const bf16x8*>(&Qw[(long)r32*QP+d0*16+hi*8]);
  float mhat=0.f,l_reg=0.f;f32x16 o[2];o[0]=f32x16{};o[1]=f32x16{};f32x16 negm=f32x16{};asm volatile("":"+v"(negm));
  #define CMASK(P0,P1,t) do{}while(0)
  bool resc=false;
  #define START(P0,P1) do{ const float rm=rowmax(P0,P1); resc=false; \
    { const float dl=rm; mhat=fadd_s(mhat,dl); \
      _Pragma("unroll") for(int r=0;r<16;++r){P0[r]=fsub_s(P0[r],dl);P1[r]=fsub_s(P1[r],dl);} \
      _Pragma("unroll") for(int r=0;r<16;++r)negm[r]=-mhat; asm volatile("":"+v"(negm)); } \
    _Pragma("unroll") for(int r=0;r<16;++r)P0[r]=__builtin_amdgcn_exp2f(P0[r]); }while(0)
  #define RESC() do{ if(resc){ asm volatile("s_waitcnt lgkmcnt(0)":::"memory"); \
      _Pragma("unroll") for(int d_=0;d_<2;++d_) _Pragma("unroll") for(int r=0;r<16;++r)o[d_][r]*=wsf[crow(r,hi)]; } }while(0)
  f32x16 pA0,pA1,pB0,pB1;
  int sl_prev=0,sl_cur=0,sl_next=SLOTB;
  #define ROT() do{sl_prev=sl_cur;sl_cur=sl_next;sl_next=(sl_next==(NSLOT-1)*SLOTB)?0:sl_next+SLOTB;}while(0)
  DMA_K(2,2*SLOTB);
  WAIT_BAR(3);
  qkt(pA0,pA1,Kbase,qr,negm,r32,hi);asm volatile("s_nop 15\n\ts_nop 7":"+v"(pA0),"+v"(pA1));CMASK(pA0,pA1,0);
  START(pA0,pA1);
  _Pragma("unroll") for(int r=0;r<16;++r)pA1[r]=__builtin_amdgcn_exp2f(pA1[r]);
  WAIT_BAR(0);
  DMA_K(3,0);DMA_V(1,SLOTB);
  ROT();
  kload8(kf,kp0+sl_cur);
  WAIT_BAR(2);
  s16x4 vlo[8],vhi[8]; u32x4 pw0,pw1,pw2,pw3;
  #define PKW(P,B) cvtpk_s(P[B],P[B+1])
  #define PAF(k) __builtin_bit_cast(bf16x8,pw##k)
  #define VFR(i) (bf16x8){vlo[i][0],vlo[i][1],vlo[i][2],vlo[i][3],vhi[i][0],vhi[i][1],vhi[i][2],vhi[i][3]}
  #define PIN(x) asm volatile("":"+v"(x))
  #define MX3(a,b,c) __builtin_fmaxf(__builtin_fmaxf((a),(b)),(c))
  #define GAPA(MF,A0,A1,A2,A3,W0,W1,PW) do{ MF; sacc+=A0; sacc+=A1; sacc+=A2; sacc+=A3; PIN(sacc); W0; W1; PIN(PW); SBAR(); }while(0)
  #define EX(v) __builtin_amdgcn_exp2f(v)
  #define GAPB(MF,X,B) do{ MF; X[B]=EX(X[B]); X[B+1]=EX(X[B+1]); X[B+2]=EX(X[B+2]); X[B+3]=EX(X[B+3]); PIN(X); SBAR(); }while(0)
  #define VRD(i) do{ vlo[i]=vtr(vp_+(((i)>>2)*4096+((i)&3)*1024)); vhi[i]=vtr(vp_+(((i)>>2)*4096+((i)&3)*1024+512)); }while(0)
  #define KRD(G,j) do{ if(G){ kload2(kf,kp0+sl_next,j); SBAR(); } }while(0)
  #define STEP(C0,C1,P0,P1,t,GK,GV,GL) do{ SBAR(); \
    const lds_cptr vp_=vp0+sl_prev; \
    VRD(0); SBAR(); float sacc=(P0[0]+P0[1]); \
    GAPA(C0=__builtin_amdgcn_mfma_f32_32x32x16_bf16(kf[0],qr[0],negm,0,0,0), P0[2],P0[3],P0[4],P0[5],     pw0[0]=PKW(P0,0), pw0[1]=PKW(P0,2), pw0); \
    VRD(4); SBAR(); GAPA(C1=__builtin_amdgcn_mfma_f32_32x32x16_bf16(kf[1],qr[0],negm,0,0,0), P0[6],P0[7],P0[8],P0[9],     pw0[2]=PKW(P0,4), pw0[3]=PKW(P0,6), pw0); \
    VRD(1); SBAR(); GAPA(C0=__builtin_amdgcn_mfma_f32_32x32x16_bf16(kf[2],qr[1],C0,0,0,0),   P0[10],P0[11],P0[12],P0[13], pw1[0]=PKW(P0,8), pw1[1]=PKW(P0,10), pw1); \
    VRD(5); SBAR(); GAPA(C1=__builtin_amdgcn_mfma_f32_32x32x16_bf16(kf[3],qr[1],C1,0,0,0),   P0[14],P0[15],P1[0],P1[1],   pw1[2]=PKW(P0,12),pw1[3]=PKW(P0,14), pw1); \
    VRD(2); SBAR(); GAPA(C0=__builtin_amdgcn_mfma_f32_32x32x16_bf16(kf[4],qr[2],C0,0,0,0),   P1[2],P1[3],P1[4],P1[5],     pw2[0]=PKW(P1,0), pw2[1]=PKW(P1,2), pw2); \
    VRD(6); SBAR(); GAPA(C1=__builtin_amdgcn_mfma_f32_32x32x16_bf16(kf[5],qr[2],C1,0,0,0),   P1[6],P1[7],P1[8],P1[9],     pw2[2]=PKW(P1,4), pw2[3]=PKW(P1,6), pw2); \
    VRD(3); SBAR(); GAPA(C0=__builtin_amdgcn_mfma_f32_32x32x16_bf16(kf[6],qr[3],C0,0,0,0),   P1[10],P1[11],P1[12],P1[13], pw3[0]=PKW(P1,8), pw3[1]=PKW(P1,10), pw3); \
    VRD(7); SBAR(); GAPA(C1=__builtin_amdgcn_mfma_f32_32x32x16_bf16(kf[7],qr[3],C1,0,0,0),   P1[14],P1[15],0.f,0.f,       pw3[2]=PKW(P1,12),pw3[3]=PKW(P1,14), pw3); \
    l_reg+=sacc; \
    if(GK){DMA_K((t)+3,sl_cur);} if(GV){DMA_V((t)+1,sl_next);} \
    CMASK(C0,C1,t); \
    { float a=MX3(C0[0],C0[1],C1[0]),b=MX3(C0[2],C0[3],C1[1]); a=MX3(a,C1[2],C1[3]); \
      _Pragma("unroll") for(int r=4;r<16;r+=4){a=MX3(a,C0[r],C0[r+1]);b=MX3(b,C0[r+2],C0[r+3]);a=MX3(a,C1[r],C1[r+1]);b=MX3(b,C1[r+2],C1[r+3]);} \
      float rm=__builtin_fmaxf(a,b); { auto rr=__builtin_amdgcn_permlane32_swap(__float_as_uint(rm),__float_as_uint(rm),false,false); rm=__builtin_fmaxf(__uint_as_float(rr[0]),__uint_as_float(rr[1])); } \
      resc=false; \
      if(__builtin_expect(__any(rm>(float)THRL),0)){ const float dl=__builtin_fmaxf(rm,0.f); mhat+=dl; \
        _Pragma("unroll") for(int r=0;r<16;++r){C0[r]-=dl;C1[r]-=dl;} \
        _Pragma("unroll") for(int r=0;r<16;++r)negm[r]=-mhat; asm volatile("":"+v"(negm)); \
        const float f=__builtin_amdgcn_exp2f(-dl); l_reg*=f; if(hi==0)wsf[r32]=f; resc=true; } } \
    SBAR(); \
    GAPB(o[0]=__builtin_amdgcn_mfma_f32_32x32x16_bf16(PAF(0),VFR(0),o[0],0,0,0), C0,0); \
    GAPB(o[1]=__builtin_amdgcn_mfma_f32_32x32x16_bf16(PAF(0),VFR(4),o[1],0,0,0), C0,4); \
    KRD(GL,0); GAPB(o[0]=__builtin_amdgcn_mfma_f32_32x32x16_bf16(PAF(1),VFR(1),o[0],0,0,0), C0,8); \
    KRD(GL,1); GAPB(o[1]=__builtin_amdgcn_mfma_f32_32x32x16_bf16(PAF(1),VFR(5),o[1],0,0,0), C0,12); \
    KRD(GL,2); GAPB(o[0]=__builtin_amdgcn_mfma_f32_32x32x16_bf16(PAF(2),VFR(2),o[0],0,0,0), C1,0); \
    KRD(GL,3); GAPB(o[1]=__builtin_amdgcn_mfma_f32_32x32x16_bf16(PAF(2),VFR(6),o[1],0,0,0), C1,4); \
    GAPB(o[0]=__builtin_amdgcn_mfma_f32_32x32x16_bf16(PAF(3),VFR(3),o[0],0,0,0), C1,8); \
    GAPB(o[1]=__builtin_amdgcn_mfma_f32_32x32x16_bf16(PAF(3),VFR(7),o[1],0,0,0), C1,12); \
    }while(0)
  int t=1;
  #undef CMASK
  #define CMASK(P0,P1,t) do{}while(0)
  for(;t+5<NT;t+=2){
    STEP(pB0,pB1,pA0,pA1,t,true,true,true);     WAIT_BAR(2); RESC(); ROT();
    STEP(pA0,pA1,pB0,pB1,t+1,true,true,true);   WAIT_BAR(2); RESC(); ROT();
  }
  #undef CMASK
  #define CMASK(P0,P1,t) do{}while(0)
  #define ENDW(tt) do{ if((tt)+3<NT){WAIT_BAR(2);} else if((tt)+2<NT){WAIT_BAR(1);} else {WAIT_BAR(0);} }while(0)
  for(;t+1<NT;t+=2){
    STEP(pB0,pB1,pA0,pA1,t,(t+3<NT),(t+1<NT),(t+1<NT));       ENDW(t);   RESC(); ROT();
    STEP(pA0,pA1,pB0,pB1,t+1,(t+4<NT),(t+2<NT),(t+2<NT));     ENDW(t+1); RESC(); ROT();
  }
  STEP(pB0,pB1,pA0,pA1,NT-1,false,false,false); RESC();
  { float sacc=pB0[0]+pB0[1]; _Pragma("unroll") for(int r=2;r<16;++r)sacc+=pB0[r]; _Pragma("unroll") for(int r=0;r<16;++r)sacc+=pB1[r]; l_reg+=sacc;
    pw0=(u32x4){PKW(pB0,0),PKW(pB0,2),PKW(pB0,4),PKW(pB0,6)};pw1=(u32x4){PKW(pB0,8),PKW(pB0,10),PKW(pB0,12),PKW(pB0,14)};pw2=(u32x4){PKW(pB1,0),PKW(pB1,2),PKW(pB1,4),PKW(pB1,6)};pw3=(u32x4){PKW(pB1,8),PKW(pB1,10),PKW(pB1,12),PKW(pB1,14)};
    SBAR(); pv(o,vb0+sl_cur,PAF(0),PAF(1),PAF(2),PAF(3)); }
  #undef PKW
  #undef PAF
  #undef VFR
  #undef PIN
  #undef MX3
  #undef GAPA
  #undef GAPB
  #undef EX
  #undef VRD
  #undef KRD
  #undef STEP
  #undef ENDW
  {auto rr=__builtin_amdgcn_permlane32_swap(__float_as_uint(l_reg),__float_as_uint(l_reg),false,false);l_reg=__uint_as_float(rr[0])+__uint_as_float(rr[1]);}
  if(hi==0)wsf[32+r32]=l_reg;asm volatile("s_waitcnt lgkmcnt(0)":::"memory");
  float rli[16];
  #pragma unroll
  for(int r=0;r<16;++r)rli[r]=__builtin_amdgcn_rcpf(wsf[32+crow(r,hi)]);
  bf16*Ow=O+(rowbase+q0+wid*QBLK)*QP+h*D; const bf16*Gw=AG+(rowbase+q0+wid*QBLK)*GP+h*D;
  { bf16*stg=(bf16*)(shm+LDS_OST)+wid*2048;
    #pragma unroll
    for(int r=0;r<16;++r){const int orow=crow(r,hi);
      #pragma unroll
      for(int d0=0;d0<2;++d0)stg[orow*64+d0*32+r32]=__float2bfloat16(o[d0][r]*rli[r]);}
    asm volatile("s_waitcnt lgkmcnt(0)":::"memory");
    #pragma unroll
    for(int i=0;i<4;++i){const int row=i*8+(lane>>3),ch=lane&7; const u32x4 v=*(const u32x4*)(stg+row*64+ch*8); const u32x4 g=*(const u32x4*)(Gw+(long)row*GP+ch*8); u32x4 w;
      #pragma unroll
      for(int e=0;e<4;++e){ const float a0=__uint_as_float(v[e]<<16)*__uint_as_float(g[e]<<16), a1=__uint_as_float(v[e]&0xffff0000u)*__uint_as_float(g[e]&0xffff0000u); w[e]=cvtpk_s(a0,a1); }
      ATTN_STORE16(Ow+(long)row*QP+ch*8,w);} }
  asm volatile("s_waitcnt lgkmcnt(0)\n\ts_barrier":::"memory");
  #undef DMA_K
  #undef DMA_V
  #undef CMASK
  #undef START
  #undef RESC
  #undef ROT
}
constexpr int ATTN_LDS_BYTES=LDS_BYTES;
struct AttnTensors { const bf16* Q; const bf16* K; const bf16* V; bf16* O; const bf16* AG; };
struct AttnUnit { long rowbase; int T; int h; int qb; };
struct StaticOrder {
  int x, j;
  __device__ __forceinline__ explicit StaticOrder(int grid,int block):x(block%8),j(block/8){}
  __device__ __forceinline__ bool next(int i,AttnUnit&u)const{ if(i>=4)return false;
    if(i<2){ u.rowbase=0; u.T=16384; u.h=x; u.qb=j+32*i; }
    else { const int uu=2*j+(i-2); u.rowbase=16384+(long)(x>>1)*4096; u.T=4096; u.h=4*(x&1)+(uu>>4); u.qb=uu&15; }
    return true; }
  __device__ __forceinline__ void a_ready(const AttnUnit&)const{}
  __device__ __forceinline__ void done(const AttnUnit&)const{}
};
template<class Sched,int THRL=8> __device__ __forceinline__ void attn_phase(char*lds,const AttnTensors&T,const Sched&S,int wave0){
  AttnUnit u;
  for(int i=0;S.next(i,u);++i){ S.a_ready(u); attn_unit<THRL>(u.rowbase,u.T,u.h,u.qb,T.Q,T.K,T.V,T.O,T.AG,lds,wave0); S.done(u); }
}
#undef SBAR
#undef WAIT_BAR
}

#define GAS __attribute__((address_space(1)))
#define LAS __attribute__((address_space(3)))
typedef unsigned short bf16;
typedef unsigned v4u __attribute__((ext_vector_type(4)));
typedef float f32x4 __attribute__((ext_vector_type(4)));
typedef short bf16x8 __attribute__((ext_vector_type(8)));
typedef GAS unsigned gu32;
typedef GAS unsigned long long gu64;
#define RLX_AGENT __ATOMIC_RELAXED, __HIP_MEMORY_SCOPE_AGENT
#define LDS_WAIT() asm volatile("s_waitcnt lgkmcnt(0)" ::: "memory")
#define VM_WAIT() asm volatile("s_waitcnt vmcnt(0)" ::: "memory")
__device__ __forceinline__ unsigned long long rt() { return __builtin_amdgcn_s_memrealtime(); }
__device__ __forceinline__ unsigned f2bf(float f) { unsigned u = __builtin_bit_cast(unsigned, f); return (u + 0x7fffu + ((u >> 16) & 1u)) >> 16; }
__device__ __forceinline__ unsigned pk2(float lo, float hi) { return f2bf(lo) | (f2bf(hi) << 16); }

#define XB_TMO      128
#define XB_XCNT(j)  (256  + 64 * (j))
#define XB_XSUB(j)  (1280 + 64 * (j))
#define XB_XGEN(j)  (2304 + 64 * (j))
#define XB_TOP      3328
#define XB_TOPGEN   3392
#define XCD_BAR_WORDS 3456
#define XB_SPIN_CAP (1u << 18)

__device__ __forceinline__ unsigned xb_ld(unsigned* p)              { return __hip_atomic_load(p, __ATOMIC_RELAXED, __HIP_MEMORY_SCOPE_AGENT); }
__device__ __forceinline__ unsigned xb_add(unsigned* p, unsigned v) { return __hip_atomic_fetch_add(p, v, __ATOMIC_RELAXED, __HIP_MEMORY_SCOPE_AGENT); }
__device__ __forceinline__ unsigned xb_xcc_id() { return (unsigned)__builtin_amdgcn_s_getreg((3 << 11) | 20) & 0xFu; }
#define XB_SPIN(cond, bar) do { unsigned _sp = 0; while (cond) { __builtin_amdgcn_s_sleep(1); \
    if ((++_sp & 255u) == 0u) { if (xb_ld(&(bar)[XB_TMO])) break; if (_sp > XB_SPIN_CAP) { atomicAdd(&(bar)[XB_TMO], 1u); break; } } } } while (0)

struct XcdBarrier {
    unsigned* bar; unsigned x; int wave;
    volatile LAS unsigned* st;
};

__device__ __forceinline__ XcdBarrier xcd_barrier_post(unsigned* bar, volatile LAS unsigned* st, int wave) {
    XcdBarrier b; b.bar = bar; b.x = xb_xcc_id(); b.st = st; b.wave = wave;
    if (threadIdx.x == 0) (void)xb_add(&bar[XB_XCNT(b.x)], 1u);
    return b;
}
__device__ __forceinline__ void xcd_barrier_complete(unsigned* bar, unsigned x, unsigned& nloc, unsigned& nx) {
    const unsigned G = gridDim.x * gridDim.y * gridDim.z;
    unsigned sum, cnt, mine, sp = 0u;
    for (;;) {
        sum = 0u; cnt = 0u; mine = 0u;
#pragma unroll
        for (unsigned j = 0; j < 16; ++j) { const unsigned c = xb_ld(&bar[XB_XCNT(j)]); sum += c; cnt += (c > 0u) ? 1u : 0u; mine = (j == x) ? c : mine; }
        if (sum == G) break;
        __builtin_amdgcn_s_sleep(1);
        if ((++sp & 255u) == 0u) { if (xb_ld(&bar[XB_TMO])) break; if (sp > XB_SPIN_CAP) { atomicAdd(&bar[XB_TMO], 1u); break; } }
    }
    nloc = mine > 0u ? mine : 1u; nx = cnt > 0u ? cnt : 1u;
}

__device__ __forceinline__ void xcd_barrier(const XcdBarrier& b) {
    asm volatile("s_waitcnt vmcnt(0)" ::: "memory");
    __syncthreads();
    if (b.wave == 0 && mk_lane() == 0) {
        unsigned* bar = b.bar;
        __builtin_amdgcn_s_waitcnt(0);
        unsigned nloc = b.st[0], nx = b.st[1];
        if (nloc == 0u) { xcd_barrier_complete(bar, b.x, nloc, nx); b.st[0] = nloc; b.st[1] = nx; }
        const unsigned old = xb_add(&bar[XB_XSUB(b.x)], 1u);
        const unsigned gen = old / nloc;
        if (old + 1u == (gen + 1u) * nloc) {
            __builtin_amdgcn_fence(__ATOMIC_RELEASE, "agent");
            asm volatile("s_waitcnt vmcnt(0)" ::: "memory");
            const unsigned og = xb_add(&bar[XB_TOP], 1u);
            const unsigned tg = og / nx;
            if (og + 1u == (tg + 1u) * nx) xb_add(&bar[XB_TOPGEN], 1u);
            else XB_SPIN(xb_ld(&bar[XB_TOPGEN]) == tg, bar);
            __builtin_amdgcn_fence(__ATOMIC_ACQUIRE, "agent");
            xb_add(&bar[XB_XGEN(b.x)], 1u);
            asm volatile("s_waitcnt vmcnt(0)" ::: "memory");
        } else {
            XB_SPIN(xb_ld(&bar[XB_XGEN(b.x)]) == gen, bar);
            __builtin_amdgcn_fence(__ATOMIC_ACQUIRE, "agent");
            asm volatile("s_waitcnt vmcnt(0)" ::: "memory");
        }
    }
    __syncthreads();
}

constexpr int RING_OFF = 0, RING_BYTES = 131072;
constexpr int LDSCTL_OFF = RING_BYTES, MISC_OFF = LDSCTL_OFF + 320;
constexpr int LDS_BYTES = 147456;
constexpr int GL_G = 0;
constexpr int GL_LR = 32768;
constexpr int GL_O = 0;
constexpr int GL_IMGF = 40960, GL_IMGB = 57344, GL_IMGV = 73728;
constexpr int GL_WUP = 90112;
constexpr int GL_BIAS = 98304;
constexpr int GL_BTOT = 98816;
constexpr int GL_OP = 132;
static_assert(GL_BTOT + 512 <= RING_BYTES && GL_O + 64 * GL_OP * 4 <= GL_IMGF, "GLA LDS map");

struct Frame {
    LAS unsigned char* lds;
    volatile LAS unsigned* MISC;
    gu32* ctl;
    int wave;
    int vcu, G;
};
__device__ __forceinline__ float wave_sum(float v) {
#pragma unroll
    for (int o = 1; o < 64; o <<= 1) v += __shfl_xor(v, o);
    return v;
}
__device__ __forceinline__ float bf_lo(unsigned w) { return __uint_as_float(w << 16); }
__device__ __forceinline__ float bf_hi(unsigned w) { return __uint_as_float(w & 0xffff0000u); }
__device__ __forceinline__ unsigned cvtpk(float lo, float hi) { typedef float f2_t __attribute__((ext_vector_type(2))); typedef __bf16 b2_t __attribute__((ext_vector_type(2)));
    f2_t v = {lo, hi}; b2_t b = __builtin_convertvector(v, b2_t); return __builtin_bit_cast(unsigned, b); }
__device__ __forceinline__ v4u pack8f(const float* v) { v4u w; w.x = cvtpk(v[0], v[1]); w.y = cvtpk(v[2], v[3]); w.z = cvtpk(v[4], v[5]); w.w = cvtpk(v[6], v[7]); return w; }

__device__ __forceinline__ int win_logcol(int p) {
    if (p >= 768) return p < INW ? p : -1;
    const int pn = p >> 8, q = p & 255, bj = q >> 7, wc = (q >> 5) & 3, c = q & 31;
    const int dqk = (c < 16 ? c : c + 16) + 16 * bj;
    if (pn < 2) return (4 * pn + wc) * 64 + dqk;
    if (wc < 2) return 512 + wc * 64 + dqk;
    return 640 + (wc - 2) * 64 + 32 * bj + c;
}
template <bool MAP> __device__ __forceinline__ void p0_transpose_item(const float* W, int K, int ldw, int Nphys, const float* scale, bf16* WT, LAS float* scr, int item, int lane) {
    const int nblk = Nphys / 32, kb = item / nblk, nb = item % nblk, k0 = 64 * kb, n0 = 32 * nb;
    const int nl = MAP ? win_logcol(n0 + (lane & 31)) : n0 + (lane & 31);
#pragma unroll 8
    for (int i = 0; i < 32; ++i) { const int kk = 2 * i + (lane >> 5); float v = 0.f;
        if (nl >= 0) { v = W[(size_t)(k0 + kk) * ldw + nl]; if (scale) v *= scale[k0 + kk]; }
        scr[kk * 33 + (lane & 31)] = v; }
    LDS_WAIT(); asm volatile("" ::: "memory");
    const int c = lane & 7;
#pragma unroll
    for (int j = 0; j < 4; ++j) { const int n = (lane >> 3) + 8 * j; const LAS float* s = scr + (8 * c) * 33 + n;
        v4u o; o.x = pk2(s[0 * 33], s[1 * 33]); o.y = pk2(s[2 * 33], s[3 * 33]); o.z = pk2(s[4 * 33], s[5 * 33]); o.w = pk2(s[6 * 33], s[7 * 33]);
        *(GAS v4u*)(WT + (size_t)(n0 + n) * K + k0 + 8 * c) = o; }
    LDS_WAIT(); asm volatile("" ::: "memory");
}
__device__ __forceinline__ void sincos_d(double a, double& s, double& c) {
    const double kq = __builtin_rint(a * 0.6366197723675814);
    double r = __builtin_fma(-kq, 1.5707963267948966, a); r = __builtin_fma(-kq, 6.123233995736766e-17, r);
    const double r2 = r * r;
    const double sp = r * (1.0 + r2 * (-1.0 / 6.0 + r2 * (1.0 / 120.0 + r2 * (-1.0 / 5040.0 + r2 * (1.0 / 362880.0 + r2 * (-1.0 / 39916800.0 + r2 * (1.0 / 6227020800.0)))))));
    const double cp = 1.0 + r2 * (-0.5 + r2 * (1.0 / 24.0 + r2 * (-1.0 / 720.0 + r2 * (1.0 / 40320.0 + r2 * (-1.0 / 3628800.0 + r2 * (1.0 / 479001600.0 + r2 * (-1.0 / 87178291200.0)))))));
    const int q = (int)((long long)kq & 3);
    s = (q == 0) ? sp : (q == 1) ? cp : (q == 2) ? -sp : -cp;
    c = (q == 0) ? cp : (q == 1) ? -sp : (q == 2) ? -cp : sp;
}
__device__ __forceinline__ float rope_inv_freq(int i) {
    const float f[16] = {1.000000000e+00f, 5.623413324e-01f, 3.162277639e-01f, 1.778279394e-01f, 1.000000015e-01f, 5.623413250e-02f, 3.162277490e-02f, 1.778279431e-02f,
                         9.999999776e-03f, 5.623413250e-03f, 3.162277630e-03f, 1.778279431e-03f, 1.000000047e-03f, 5.623413017e-04f, 3.162277571e-04f, 1.778279402e-04f};
    float r = f[0];
#pragma unroll
    for (int k = 1; k < 16; ++k) r = (i == k) ? f[k] : r;
    return r;
}

struct Ptrs {
    const float *xp, *xs, *pp_, *ps, *mix_norm, *w_in, *q_norm, *k_norm, *wup_f, *bup_f, *wup_b, *bup_b, *gla_norm, *w_out, *ple_norm, *w_pg, *w_pp, *final_norm;
    float* out; unsigned char* ws;
};

__device__ __forceinline__ void p0_prologue(Frame& F, const Ptrs& P) {
    const int lane = mk_lane(), tid = F.wave * 64 + lane;
    LAS float* scr = (LAS float*)(F.lds + RING_OFF + F.wave * 16384);
    const int gw = F.vcu * NWAVES + F.wave, NGW = F.G * NWAVES;
    bf16* Win_t = (bf16*)(P.ws + WS_WIN); bf16* Wout_t = (bf16*)(P.ws + WS_WOUT); bf16* Wpg_t = (bf16*)(P.ws + WS_WPG); bf16* Wpp_t = (bf16*)(P.ws + WS_WPP);
    constexpr int I_IN = (DMODEL / 64) * (NPHYS / 32), I_O = (DMODEL / 64) * (DMODEL / 32), I_PG = I_O, I_PP = (PLE / 64) * (DMODEL / 32);
    constexpr int NITEMS = I_IN + I_O + I_PG + I_PP;
    for (int it = gw; it < NITEMS; it += NGW) {
        int r = it;
        if (r < I_IN) { p0_transpose_item<true>(P.w_in, DMODEL, INW, NPHYS, P.mix_norm, Win_t, scr, r, lane); continue; } r -= I_IN;
        if (r < I_O)  { p0_transpose_item<false>(P.w_out, DMODEL, DMODEL, DMODEL, nullptr, Wout_t, scr, r, lane); continue; } r -= I_O;
        if (r < I_PG) { p0_transpose_item<false>(P.w_pg, DMODEL, DMODEL, DMODEL, P.ple_norm, Wpg_t, scr, r, lane); continue; } r -= I_PG;
        p0_transpose_item<false>(P.w_pp, PLE, DMODEL, DMODEL, nullptr, Wpp_t, scr, r, lane);
    }
    bf16* XB = (bf16*)((unsigned char*)P.out + OUT_XB); float* RS = (float*)(P.ws + WS_RS);
    for (int m = gw; m < NTOK; m += NGW) {
        const float* xrow = m < NPR ? P.xp + (size_t)m * DMODEL : P.xs + (size_t)(m - NPR) * DMODEL;
        const GAS f32x4* xr = (const GAS f32x4*)xrow + lane;
        f32x4 v[4]; float s = 0.f;
#pragma unroll
        for (int j = 0; j < 4; ++j) { v[j] = xr[64 * j]; s += (v[j].x * v[j].x + v[j].y * v[j].y) + (v[j].z * v[j].z + v[j].w * v[j].w); }
        s = wave_sum(s);
        GAS unsigned long long* o8 = (GAS unsigned long long*)(XB + (size_t)m * DMODEL) + lane;
#pragma unroll
        for (int j = 0; j < 4; ++j) o8[64 * j] = (unsigned long long)pk2(v[j].x, v[j].y) | ((unsigned long long)pk2(v[j].z, v[j].w) << 32);
        if (lane == 0) RS[m] = rsqrtf(s * (1.0f / DMODEL) + EPS);
    }
    bf16* PB = (bf16*)(P.ws + WS_PB);
    const int gt = F.vcu * NWAVES * 64 + tid, NGT = F.G * NWAVES * 64;
    for (int i = gt; i < NTOK * PLE / 8; i += NGT) {
        const size_t e = (size_t)i * 8; const float* src = e < (size_t)NPR * PLE ? P.pp_ + e : P.ps + (e - (size_t)NPR * PLE);
        const f32x4 a = *(const f32x4*)src, b = *(const f32x4*)(src + 4);
        v4u o; o.x = pk2(a.x, a.y); o.y = pk2(a.z, a.w); o.z = pk2(b.x, b.y); o.w = pk2(b.z, b.w);
        *(v4u*)(PB + e) = o;
    }
    { float* C = (float*)(P.ws + WS_CONST);
      for (int i = gt; i < CO_END; i += NGT) { float v;
          if (i < CO_KN) v = P.q_norm[i - CO_QN]; else if (i < CO_GN) v = P.k_norm[i - CO_KN]; else if (i < CO_FN) v = P.gla_norm[i - CO_GN]; else if (i < CO_BF) v = P.final_norm[i - CO_FN];
          else if (i < CO_BB) v = P.bup_f[i - CO_BF]; else if (i < CO_WF) v = P.bup_b[i - CO_BB]; else if (i < CO_WB) v = P.wup_f[i - CO_WF]; else v = P.wup_b[i - CO_WB];
          C[i] = v; } }
    for (int i = gt; i < 320 * 16; i += NGT) {
        const int pos = i >> 4, fi = i & 15;
        const bool isrow = pos < 256; const int pp = isrow ? pos : pos - 256;
        const float ang = (float)pp * rope_inv_freq(fi);
        double s, c; sincos_d((double)ang, s, c);
        float* dst = (float*)(P.ws + (isrow ? WS_ROPE_ROW : WS_ROPE_COL)) + ((size_t)pp * 16 + fi) * 2;
        dst[0] = (float)c; dst[1] = (float)s;
    }
}

typedef short v4i16_t __attribute__((ext_vector_type(4)));
typedef float f32x16 __attribute__((ext_vector_type(16)));
__device__ __forceinline__ unsigned img_off(unsigned row, unsigned ch) { return 256u * row + 16u * (ch ^ (((row & 3u) << 2) | ((row >> 2) & 3u))); }
__device__ __forceinline__ bf16x8 img_row_frag(LAS unsigned char* img, int R0, int s, int lane) { return *(const LAS bf16x8*)(img + img_off((unsigned)(R0 + (lane & 31)), (unsigned)(2 * s + (lane >> 5)))); }
template <bool PERMK> __device__ __forceinline__ bf16x8 img_tr_frag(LAS unsigned char* img, int c, int ks, int lane) {
    const unsigned h = lane >> 5, blk = (lane >> 4) & 1, q = (lane & 15) >> 2, p = lane & 3;
    const unsigned r0 = PERMK ? (16 * ks + 4 * h + q) : (16 * ks + 8 * h + q), r1 = PERMK ? r0 + 8 : r0 + 4, ch = 4 * c + 2 * blk + (p >> 1);
    const v4i16_t lo = __builtin_amdgcn_ds_read_tr16_b64_v4i16((LAS v4i16_t*)(img + img_off(r0, ch) + 8 * (p & 1)));
    const v4i16_t hi = __builtin_amdgcn_ds_read_tr16_b64_v4i16((LAS v4i16_t*)(img + img_off(r1, ch) + 8 * (p & 1)));
    return (bf16x8){lo[0], lo[1], lo[2], lo[3], hi[0], hi[1], hi[2], hi[3]};
}
#define MFMA32(a, b, c) __builtin_amdgcn_mfma_f32_32x32x16_bf16((a), (b), (c), 0, 0, 0)
__device__ __forceinline__ int crow16(int r, int hi) { return (r & 3) + 8 * (r >> 2) + 4 * hi; }

__device__ __forceinline__ void gla_decay_sums(Frame& F, const Ptrs& P, int cg) {
    LAS float* LG_ = (LAS float*)(F.lds + GL_G); LAS float* LLR = (LAS float*)(F.lds + GL_LR);
    LAS float* LW = (LAS float*)(F.lds + GL_WUP); LAS float* LB = (LAS float*)(F.lds + GL_BIAS); LAS float* LT = (LAS float*)(F.lds + GL_BTOT);
    const int tid = F.wave * 64 + mk_lane(); const size_t tok0 = (size_t)cg * 64;
    { const float* lr = (const float*)(P.ws + WS_LR) + tok0 * 32; *(LAS f32x4*)(LLR + tid * 4) = *(const f32x4*)(lr + tid * 4); }
    __syncthreads();
    { const int t = tid >> 3, d0 = (tid & 7) * 8;
#pragma unroll
      for (int dir = 0; dir < 2; ++dir) {
          float x[8];
#pragma unroll
          for (int e = 0; e < 8; ++e) x[e] = LB[dir * 64 + d0 + e];
#pragma unroll
          for (int r = 0; r < 16; ++r) { const float l = LLR[t * 32 + dir * 16 + r]; const LAS float* w = LW + (dir * 16 + r) * 64 + d0;
#pragma unroll
              for (int e = 0; e < 8; ++e) x[e] += l * w[e]; }
#pragma unroll
          for (int e = 0; e < 8; ++e) { const float xe = x[e]; const float ls = fminf(xe, 0.f) - __logf(1.f + __expf(-fabsf(xe))); LG_[(dir * 64 + t) * 64 + d0 + e] = ls * (1.0f / 16.0f); }
      } }
    __syncthreads();
    if (tid < 128) { const int dir = tid >> 6, d = tid & 63; float a = 0.f;
        if (dir == 0) { for (int t = 0; t < 64; ++t) { a += LG_[t * 64 + d]; LG_[t * 64 + d] = a; } }
        else { for (int t = 63; t >= 0; --t) { a += LG_[(64 + t) * 64 + d]; LG_[(64 + t) * 64 + d] = a; } }
        LT[dir * 64 + d] = a; }
    __syncthreads();
}
__device__ __forceinline__ void gla_load_wup(Frame& F, const Ptrs& P, int h) {
    LAS float* LW = (LAS float*)(F.lds + GL_WUP); LAS float* LB = (LAS float*)(F.lds + GL_BIAS); const int tid = F.wave * 64 + mk_lane();
    for (int i = tid; i < 2048; i += NWAVES * 64) { const int dir = i >> 10, r = (i >> 6) & 15, d = i & 63; LW[i] = ((const float*)(P.ws + WS_CONST))[(dir ? CO_WB : CO_WF) + r * 256 + h * 64 + d]; }
    if (tid < 128) { const int dir = tid >> 6, d = tid & 63; LB[tid] = ((const float*)(P.ws + WS_CONST))[(dir ? CO_BB : CO_BF) + h * 64 + d]; }
    __syncthreads();
}
__device__ __forceinline__ void gla_copy_v(Frame& F, const Ptrs& P, int cg, int h) {
    const bf16* LV = (const bf16*)(P.ws + WS_LV); const int tid = F.wave * 64 + mk_lane();
#pragma unroll
    for (int i = 0; i < 2; ++i) { const int idx = tid + 512 * i, t = idx >> 4, ch = idx & 15;
        const v4u v = *(const v4u*)(LV + ((size_t)cg * 64 + t) * 512 + h * 128 + ch * 8);
        *(LAS v4u*)(F.lds + GL_IMGV + img_off(t, ch)) = v; }
}

__device__ __forceinline__ void p2_gla_states(Frame& F, const Ptrs& P) {
    const int h = blockIdx.x & 3; const int lane = mk_lane(), tid = F.wave * 64 + lane, wid = F.wave, hi = lane >> 5, r32 = lane & 31;
    bf16* ST = (bf16*)((unsigned char*)P.out + OUT_ST); float* DEC = (float*)(P.ws + WS_DEC);
    const bf16* LK = (const bf16*)(P.ws + WS_LK);
    LAS float* LG_ = (LAS float*)(F.lds + GL_G); LAS float* LT = (LAS float*)(F.lds + GL_BTOT);
    gla_load_wup(F, P, h);
    for (int u = blockIdx.x; u < 2048; u += F.G) {
        const int cg = u >> 2;
        gla_decay_sums(F, P, cg);
        { const int t = tid >> 3, ch = tid & 7;
          const v4u kv = *(const v4u*)(LK + ((size_t)cg * 64 + t) * 256 + h * 64 + ch * 8);
          float kf[8], kb[8];
#pragma unroll
          for (int e = 0; e < 8; ++e) { const unsigned w = kv[e >> 1]; const float k = (e & 1) ? bf_hi(w) : bf_lo(w); const int d = ch * 8 + e;
              kf[e] = k * __expf(LT[d] - LG_[t * 64 + d]); kb[e] = k * __expf(LT[64 + d] - LG_[(64 + t) * 64 + d]); }
          *(LAS v4u*)(F.lds + GL_IMGF + img_off(t, ch)) = pack8f(kf); *(LAS v4u*)(F.lds + GL_IMGF + img_off(t, 8 + ch)) = pack8f(kb); }
        gla_copy_v(F, P, cg, h);
        if (tid < 128) DEC[(size_t)u * 128 + tid] = __expf(LT[tid]);
        __syncthreads();
        { const int c = wid >> 1, e = wid & 1;
#pragma unroll
          for (int dir = 0; dir < 2; ++dir) {
              f32x16 acc = {};
#pragma unroll
              for (int ks = 0; ks < 4; ++ks) {
                  const bf16x8 a = img_tr_frag<false>(F.lds + GL_IMGF, 2 * dir + e, ks, lane);
                  const bf16x8 b = img_tr_frag<false>(F.lds + GL_IMGV, c, ks, lane);
                  acc = MFMA32(a, b, acc);
              }
              bf16* dst = ST + ((size_t)(u * 2 + dir) * 128 + 32 * c + r32) * 64 + 32 * e + 4 * hi;
#pragma unroll
              for (int g = 0; g < 4; ++g) { uint2 w; w.x = cvtpk(acc[4 * g], acc[4 * g + 1]); w.y = cvtpk(acc[4 * g + 2], acc[4 * g + 3]); *(uint2*)(dst + 8 * g) = w; }
          } }
        __syncthreads();
    }
}

__device__ __forceinline__ void p3_gla_scan(Frame& F, const Ptrs& P) {
    bf16* ST = (bf16*)((unsigned char*)P.out + OUT_ST); const float* DEC = (const float*)(P.ws + WS_DEC);
    const int lane = mk_lane();
    const int item = F.wave * 256 + (int)blockIdx.x;
    if (item < 640) {
        int seq, r; if (item < 128) { seq = 0; r = item; } else { r = item - 128; seq = 1 + (r >> 7); r &= 127; }
        const int hh = r >> 5, dir = (r >> 4) & 1, part = r & 15;
        const int N = seq == 0 ? 256 : 64, cg0 = seq == 0 ? 0 : 256 + (seq - 1) * 64;
        const int dv = part * 8 + (lane >> 3), dk8 = (lane & 7) * 8;
        float S[8];
#pragma unroll
        for (int e = 0; e < 8; ++e) S[e] = 0.f;
        for (int i = 0; i < N; i += 4) {
            v4u kvv[4]; f32x4 da[4], db[4]; bf16* pp[4];
#pragma unroll
            for (int q = 0; q < 4; ++q) { const int n = dir ? N - 1 - (i + q) : i + q; const size_t ud = (size_t)((cg0 + n) * 4 + hh) * 2 + dir;
                pp[q] = ST + (ud * 128 + dv) * 64 + dk8; kvv[q] = *(const v4u*)pp[q];
                const float* dc = DEC + ud * 64 + dk8; da[q] = *(const f32x4*)dc; db[q] = *(const f32x4*)(dc + 4); }
#pragma unroll
            for (int q = 0; q < 4; ++q) {
                *(v4u*)pp[q] = pack8f(S);
                const float dcy[8] = {da[q][0], da[q][1], da[q][2], da[q][3], db[q][0], db[q][1], db[q][2], db[q][3]};
#pragma unroll
                for (int e = 0; e < 8; ++e) { const unsigned w = kvv[q][e >> 1]; const float kv = (e & 1) ? bf_hi(w) : bf_lo(w); S[e] = dcy[e] * S[e] + kv; }
            }
        }
    }
}

__device__ __forceinline__ void p4_gla_out(Frame& F, const Ptrs& P) {
    const int h = blockIdx.x & 3; const int lane = mk_lane(), tid = F.wave * 64 + lane, wid = F.wave, hi = lane >> 5, r32 = lane & 31;
    const bf16* ST = (const bf16*)((unsigned char*)P.out + OUT_ST);
    const bf16* LQ = (const bf16*)(P.ws + WS_LQ); const bf16* LK = (const bf16*)(P.ws + WS_LK); const bf16* LGt = (const bf16*)(P.ws + WS_LG);
    bf16* MIX = (bf16*)(P.ws + WS_MIX);
    LAS float* LG_ = (LAS float*)(F.lds + GL_G); LAS float* LO = (LAS float*)(F.lds + GL_O);
    LAS unsigned char* IMGF = F.lds + GL_IMGF; LAS unsigned char* IMGB = F.lds + GL_IMGB; LAS unsigned char* IMGV = F.lds + GL_IMGV;
    gla_load_wup(F, P, h);
    for (int u = blockIdx.x; u < 2048; u += F.G) {
        const int cg = u >> 2;
        gla_decay_sums(F, P, cg);
        { const int t = tid >> 3, ch = tid & 7;
          const v4u qv = *(const v4u*)(LQ + ((size_t)cg * 64 + t) * 256 + h * 64 + ch * 8);
          const v4u kv = *(const v4u*)(LK + ((size_t)cg * 64 + t) * 256 + h * 64 + ch * 8);
          float qf[8], kf[8], qb[8], kb[8];
#pragma unroll
          for (int e = 0; e < 8; ++e) { const unsigned wq = qv[e >> 1], wk = kv[e >> 1]; const float q = ((e & 1) ? bf_hi(wq) : bf_lo(wq)) * 0.125f, k = (e & 1) ? bf_hi(wk) : bf_lo(wk);
              const int d = ch * 8 + e; const float bf = LG_[t * 64 + d], bb = LG_[(64 + t) * 64 + d];
              qf[e] = q * __expf(bf); kf[e] = k * __expf(-bf); qb[e] = q * __expf(bb); kb[e] = k * __expf(-bb); }
          *(LAS v4u*)(IMGF + img_off(t, ch)) = pack8f(qf); *(LAS v4u*)(IMGF + img_off(t, 8 + ch)) = pack8f(kf);
          *(LAS v4u*)(IMGB + img_off(t, ch)) = pack8f(qb); *(LAS v4u*)(IMGB + img_off(t, 8 + ch)) = pack8f(kb); }
        gla_copy_v(F, P, cg, h);
        __syncthreads();
        f32x16 o = {};
        { const int tau = wid >> 2, c = wid & 3;
#pragma unroll
          for (int sg = 0; sg < 2; ++sg) {
              f32x16 xf = {}, xb = {};
#pragma unroll
              for (int kk = 0; kk < 4; ++kk) {
                  xf = MFMA32(img_row_frag(IMGF, 32 * sg, 4 + kk, lane), img_row_frag(IMGF, 32 * tau, kk, lane), xf);
                  xb = MFMA32(img_row_frag(IMGB, 32 * sg, 4 + kk, lane), img_row_frag(IMGB, 32 * tau, kk, lane), xb);
              }
              float x[16];
#pragma unroll
              for (int r = 0; r < 16; ++r) { const int s = 32 * sg + crow16(r, hi), t = 32 * tau + r32; x[r] = (s <= t) ? xf[r] : xb[r]; }
#pragma unroll
              for (int s2 = 0; s2 < 2; ++s2) {
                  v4u aw; aw.x = cvtpk(x[8 * s2], x[8 * s2 + 1]); aw.y = cvtpk(x[8 * s2 + 2], x[8 * s2 + 3]); aw.z = cvtpk(x[8 * s2 + 4], x[8 * s2 + 5]); aw.w = cvtpk(x[8 * s2 + 6], x[8 * s2 + 7]);
                  o = MFMA32(__builtin_bit_cast(bf16x8, aw), img_tr_frag<true>(IMGV, c, 2 * sg + s2, lane), o);
              }
          }
          const bf16* sf = ST + ((size_t)(u * 2 + 0) * 128 + 32 * c + r32) * 64 + 8 * hi; const bf16* sb = sf + 128 * 64;
#pragma unroll
          for (int kk = 0; kk < 4; ++kk) {
              const bf16x8 bfr = *(const bf16x8*)(sf + 16 * kk), bbr = *(const bf16x8*)(sb + 16 * kk);
              o = MFMA32(img_row_frag(IMGF, 32 * tau, kk, lane), bfr, o);
              o = MFMA32(img_row_frag(IMGB, 32 * tau, kk, lane), bbr, o);
          }
          __syncthreads();
#pragma unroll
          for (int r = 0; r < 16; ++r) LO[(32 * tau + crow16(r, hi)) * GL_OP + 32 * c + r32] = o[r];
        }
        __syncthreads();
        { const int t = tid >> 3, seg = tid & 7;
          float v[16]; float ss = 0.f;
#pragma unroll
          for (int i = 0; i < 4; ++i) { const f32x4 a = *(const LAS f32x4*)(LO + t * GL_OP + seg * 16 + 4 * i); v[4 * i] = a[0]; v[4 * i + 1] = a[1]; v[4 * i + 2] = a[2]; v[4 * i + 3] = a[3];
              ss += (a[0] * a[0] + a[1] * a[1]) + (a[2] * a[2] + a[3] * a[3]); }
          ss += __shfl_xor(ss, 1); ss += __shfl_xor(ss, 2); ss += __shfl_xor(ss, 4);
          const float inv = rsqrtf(ss * (1.0f / 128.0f) + EPS);
          const size_t tok = (size_t)cg * 64 + t;
          const v4u g0 = *(const v4u*)(LGt + tok * 512 + h * 128 + seg * 16), g1 = *(const v4u*)(LGt + tok * 512 + h * 128 + seg * 16 + 8);
          float y[16];
#pragma unroll
          for (int e = 0; e < 16; ++e) { const unsigned w = e < 8 ? g0[e >> 1] : g1[(e - 8) >> 1]; const float gt = (e & 1) ? bf_hi(w) : bf_lo(w);
              y[e] = v[e] * inv * ((const float*)(P.ws + WS_CONST))[CO_GN + seg * 16 + e] * gt; }
          bf16* dst = MIX + tok * 1024 + 512 + h * 128 + seg * 16;
          *(v4u*)dst = pack8f(y); *(v4u*)(dst + 8) = pack8f(y + 8); }
        __syncthreads();
    }
}

__device__ __forceinline__ void p7_final_norm(Frame& F, const Ptrs& P) {
    const int lane = mk_lane(); const int gw = F.vcu * NWAVES + F.wave, NGW = F.G * NWAVES; const float* SS2 = (const float*)(P.ws + WS_SS2);
    f32x4 fn[4];
#pragma unroll
    for (int j = 0; j < 4; ++j) fn[j] = *(const f32x4*)((const float*)(P.ws + WS_CONST) + CO_FN + 256 * j + 4 * lane);
    for (int m = gw; m < NTOK; m += NGW) {
        const f32x4* sp = (const f32x4*)(SS2 + (size_t)m * 16); const f32x4 s0 = sp[0], s1 = sp[1], s2 = sp[2], s3 = sp[3];
        const float tot = ((s0[0] + s0[1]) + (s0[2] + s0[3])) + ((s1[0] + s1[1]) + (s1[2] + s1[3])) + ((s2[0] + s2[1]) + (s2[2] + s2[3])) + ((s3[0] + s3[1]) + (s3[2] + s3[3]));
        const float inv = rsqrtf(tot * (1.0f / DMODEL) + EPS);
        GAS f32x4* o = (GAS f32x4*)(P.out + (size_t)m * DMODEL) + lane;
#pragma unroll
        for (int j = 0; j < 4; ++j) { const f32x4 v = o[64 * j]; o[64 * j] = v * inv * fn[j]; }
    }
}

struct Args { const float* in[18]; float* out; unsigned char* ws; int ph_lo, ph_hi, use_bar, pad; };
__global__ void __launch_bounds__(NWAVES * 64, 2) hymba_fwd(Args args) {
    extern __shared__ __attribute__((aligned(16))) unsigned char lds[];
    Frame F;
    F.lds = (LAS unsigned char*)lds;
    F.MISC = (volatile LAS unsigned*)(F.lds + MISC_OFF);
    F.wave = __builtin_amdgcn_readfirstlane((int)threadIdx.x >> 6);
    F.G = gridDim.x; { const int bx = blockIdx.x; F.vcu = (F.G % 8 == 0) ? (bx % 8) * (F.G / 8) + bx / 8 : bx; }
    Ptrs P;
    P.xp = args.in[0]; P.xs = args.in[1]; P.pp_ = args.in[2]; P.ps = args.in[3]; P.mix_norm = args.in[4]; P.w_in = args.in[5]; P.q_norm = args.in[6]; P.k_norm = args.in[7];
    P.wup_f = args.in[8]; P.bup_f = args.in[9]; P.wup_b = args.in[10]; P.bup_b = args.in[11]; P.gla_norm = args.in[12]; P.w_out = args.in[13]; P.ple_norm = args.in[14];
    P.w_pg = args.in[15]; P.w_pp = args.in[16]; P.final_norm = args.in[17]; P.out = args.out; P.ws = args.ws;
    F.ctl = (gu32*)(P.ws + WS_CTL);
    for (int u = threadIdx.x; u < (LDS_BYTES - LDSCTL_OFF) / 4; u += NWAVES * 64) ((LAS unsigned*)(F.lds + LDSCTL_OFF))[u] = 0u;
    __syncthreads();
    XcdBarrier bar; bar.bar = (unsigned*)(F.ctl + CW_BAR); bar.x = 0; bar.st = nullptr; bar.wave = F.wave;
    if (args.use_bar) bar = xcd_barrier_post((unsigned*)(F.ctl + CW_BAR), F.MISC + 8, F.wave);
    const int lo = args.ph_lo, hi = args.ph_hi;
#define IN(k) (lo <= (k) && (k) < hi)
#define SEAM(k) do { if (IN(k) && IN((k) + 1)) xcd_barrier(bar); } while (0)
    bf16* XB = (bf16*)((unsigned char*)P.out + OUT_XB);
    bf16* MIX = (bf16*)(P.ws + WS_MIX);

    if (IN(0)) { p0_prologue(F, P); SEAM(0); }

    if (IN(1)) {
        pg8::Gemm g{XB, (const bf16*)(P.ws + WS_WIN), NTOK, NPHYS, DMODEL}; pg8::StaticOrder S; S.init(NTOK, NPHYS, F.G, (int)blockIdx.x);
        pg8::EpiInProj E{P.ws};
        pg8::gemm_phase<pg8::EpiInProj, pg8::StaticOrder, true, true>(F.lds + RING_OFF, g, S, E, F.wave);
        SEAM(1);
    }

    if (IN(2)) { p2_gla_states(F, P); SEAM(2); }

    if (IN(3)) {
        p3_gla_scan(F, P);
        VM_WAIT(); __syncthreads();
        const attn_body::AttnTensors AT{(const attn_body::bf16*)MIX, (const attn_body::bf16*)(P.ws + WS_KB), (const attn_body::bf16*)(P.ws + WS_VB), (attn_body::bf16*)MIX, (const attn_body::bf16*)(P.ws + WS_AG)};
        const attn_body::StaticOrder S((int)F.G, (int)blockIdx.x);
        attn_body::attn_phase<attn_body::StaticOrder>((char*)lds + RING_OFF, AT, S, F.wave);
        SEAM(3);
    }

    if (IN(4)) { p4_gla_out(F, P); SEAM(4); }

    if (IN(5)) {
        { pg8::Gemm g{MIX, (const bf16*)(P.ws + WS_WOUT), NTOK, DMODEL, DMODEL}; pg8::StaticOrder S; S.init(NTOK, DMODEL, F.G, (int)blockIdx.x);
          pg8::EpiOutProj E{P.xp, P.xs, P.out, P.ws};
          pg8::gemm_phase<pg8::EpiOutProj, pg8::StaticOrder, true, true>(F.lds + RING_OFF, g, S, E, F.wave); }
        { pg8::Gemm g{(const bf16*)(P.ws + WS_PB), (const bf16*)(P.ws + WS_WPP), NTOK, DMODEL, PLE}; pg8::StaticOrder S; S.init(NTOK, DMODEL, F.G, (int)blockIdx.x);
          pg8::EpiPlainBf16 E{(bf16*)(P.ws + WS_PPB), DMODEL};
          pg8::gemm_phase<pg8::EpiPlainBf16, pg8::StaticOrder, true, true>(F.lds + RING_OFF, g, S, E, F.wave); }
        SEAM(5);
    }

    if (IN(6)) {
        pg8::Gemm g{(const bf16*)(P.ws + WS_H2B), (const bf16*)(P.ws + WS_WPG), NTOK, DMODEL, DMODEL}; pg8::StaticOrder S; S.init(NTOK, DMODEL, F.G, (int)blockIdx.x);
        pg8::EpiPle E{P.out, P.ws};
        pg8::gemm_phase<pg8::EpiPle, pg8::StaticOrder, true, true>(F.lds + RING_OFF, g, S, E, F.wave);
        SEAM(6);
    }

    if (IN(7)) { p7_final_norm(F, P); }
#undef IN
#undef SEAM
}

extern "C" void kernel_launch(void* const* d_in, const int* in_sizes, int n_in, void* d_out, int out_size, void* d_ws, size_t ws_size, hipStream_t stream) {
    static int grid = 0;
    if (grid == 0) {
        if (n_in != 18 || in_sizes[0] != NPR * DMODEL || out_size != NTOK * DMODEL || ws_size < WS_END) {
            fprintf(stderr, "kernel_launch: built for 18 inputs, %d outputs, >= %zu bytes of workspace; got n_in %d, in0 %d, out %d, ws %zu; nothing launched\n", NTOK * DMODEL, (size_t)WS_END, n_in, n_in > 0 ? in_sizes[0] : -1, out_size, ws_size); grid = -1; return; }
        int dev = 0, cus = 0, per_cu = 0;
        if (hipGetDevice(&dev) != hipSuccess || hipDeviceGetAttribute(&cus, hipDeviceAttributeMultiprocessorCount, dev) != hipSuccess) { fprintf(stderr, "kernel_launch: device query failed\n"); grid = -1; return; }
        if (hipFuncSetAttribute((const void*)hymba_fwd, hipFuncAttributeMaxDynamicSharedMemorySize, LDS_BYTES) != hipSuccess) { fprintf(stderr, "kernel_launch: hipFuncSetAttribute failed\n"); grid = -1; return; }
        if (hipOccupancyMaxActiveBlocksPerMultiprocessor(&per_cu, (const void*)hymba_fwd, NWAVES * 64, LDS_BYTES) != hipSuccess || per_cu < 1) { fprintf(stderr, "kernel_launch: occupancy query says %d blocks per CU\n", per_cu); per_cu = 1; }
        (void)hipGetLastError();
        grid = cus;
        if (grid != 256) fprintf(stderr, "kernel_launch: %d CUs; this build's static work split assumes 256\n", grid);
    }
    if (grid < 0) return;
    if (hipMemsetAsync((char*)d_ws + WS_CTL, 0, CTL_ZERO_BYTES, stream) != hipSuccess) { fprintf(stderr, "kernel_launch: hipMemsetAsync failed\n"); return; }
    Args a{};
    for (int i = 0; i < 18; ++i) a.in[i] = (const float*)d_in[i];
    a.out = (float*)d_out; a.ws = (unsigned char*)d_ws;
#if MK_DEBUG
    for (int ph = 0; ph < NPHASE; ++ph) {
        a.ph_lo = ph; a.ph_hi = ph + 1; a.use_bar = 0;
        hipLaunchKernelGGL(hymba_fwd, dim3(grid), dim3(NWAVES * 64), LDS_BYTES, stream, a);
    }
#else
    a.ph_lo = 0; a.ph_hi = NPHASE; a.use_bar = 1;
    void* kargs[] = {&a};
    const hipError_t le = hipLaunchCooperativeKernel((const void*)hymba_fwd, dim3(grid), dim3(NWAVES * 64), kargs, LDS_BYTES, stream);
    if (le != hipSuccess) fprintf(stderr, "kernel_launch: cooperative launch failed: %s (grid %d x %d threads, %d B LDS)\n", hipGetErrorName(le), grid, NWAVES * 64, LDS_BYTES);
#endif
}
```
